# Optimizing an MI355X kernel written in HIP

```python
import math
import jax, jax.numpy as jnp
from jax import lax
import numpy as np

D_MODEL = 2048
BATCH = 8
SEQ = 2048
DEPTH = 1

N_MEM = 256
HEAD_DIM = 128
ROPE_THETA = 500000.0
ROT_DIM = HEAD_DIM // 4
EPS = 1e-6
NEG = -1e30
DSWA_GROUPS = ((128, 1), (512, 4), (2048, 16))
DSWA_HEADS_PER_GROUP = 2
DSWA_HEADS = DSWA_HEADS_PER_GROUP * len(DSWA_GROUPS)
DSWA_WIDTH = DSWA_HEADS * HEAD_DIM
DSWA_OUT = DSWA_HEADS_PER_GROUP * HEAD_DIM
HY_WIDTH = 3 * D_MODEL // 8
HY_ORDER = 2
HY_SHORT = 3
HY_EMB = 33
HY_FILTER_HIDDEN = 64
HY_FAST_DECAY = 0.3
HY_SLOW_DECAY = 1.5
HY_TARGET = 1e-2
MEM_HEADS = 4
MEM_WIDTH = MEM_HEADS * HEAD_DIM
N_BRANCH = 3
D_FF = 256 * ((8 * D_MODEL // 3 + 255) // 256)
IN_WIDTH = 3 * DSWA_WIDTH + (HY_ORDER + 1) * HY_WIDTH + MEM_WIDTH + N_BRANCH * D_MODEL
IN_SPLITS = (DSWA_WIDTH, 2 * DSWA_WIDTH, 3 * DSWA_WIDTH,
             3 * DSWA_WIDTH + (HY_ORDER + 1) * HY_WIDTH,
             3 * DSWA_WIDTH + (HY_ORDER + 1) * HY_WIDTH + MEM_WIDTH)

kernel_name = 'hybrid_gated_dilated_hyena_memory_encoder_layer'

F32 = jnp.float32


def rmsnorm(x, g):
    xf = x.astype(F32)
    y = xf * lax.rsqrt(jnp.mean(xf * xf, axis=-1, keepdims=True) + EPS)
    return (y * g.astype(F32)).astype(x.dtype)


def swiglu(h, w_in, w_down):
    a, b = jnp.split(h @ w_in, 2, axis=-1)
    return (jax.nn.silu(a) * b) @ w_down


def rope_tables(seq):
    inv = jnp.power(ROPE_THETA, -jnp.arange(0, ROT_DIM, 2, dtype=F32) / ROT_DIM)
    ang = jnp.arange(seq, dtype=F32)[:, None] * inv[None, :]
    return jnp.cos(ang), jnp.sin(ang)


def partial_rope(t, cos, sin):
    tf = t.astype(F32)
    half = ROT_DIM // 2
    t1, t2 = tf[..., :half], tf[..., half:ROT_DIM]
    c, s = cos[None, :, None, :], sin[None, :, None, :]
    out = jnp.concatenate([t1 * c - t2 * s, t2 * c + t1 * s, tf[..., ROT_DIM:]], axis=-1)
    return out.astype(t.dtype)


def dilated_window_attn(q, k, v, window, dilation):
    B, S, H, Dh = q.shape
    half = window // (2 * dilation)
    L = S // dilation
    nb = -(-L // half)
    Lp = nb * half

    def sub(t):
        return t.astype(F32).reshape(B, L, dilation, H, Dh).transpose(0, 2, 1, 3, 4)

    qs = jnp.pad(sub(q), ((0, 0), (0, 0), (0, Lp - L), (0, 0), (0, 0)))
    qs = qs.reshape(B, dilation, nb, half, H, Dh)

    def windows(t):
        tp = jnp.pad(sub(t), ((0, 0), (0, 0), (half, Lp - L + half), (0, 0), (0, 0)))
        tp = tp.reshape(B, dilation, nb + 2, half, H, Dh)
        return jnp.concatenate([tp[:, :, :-2], tp[:, :, 1:-1], tp[:, :, 2:]], axis=3)

    kw, vw = windows(k), windows(v)
    s = jnp.einsum('bdnqhe,bdnkhe->bdnhqk', qs, kw) / math.sqrt(Dh)
    qi = jnp.arange(half)[:, None]
    kj = jnp.arange(3 * half)[None, :]
    rel = kj - half - qi
    kpos = jnp.arange(nb)[:, None, None] * half - half + kj[None]
    valid = (jnp.abs(rel) <= half)[None] & (kpos >= 0) & (kpos < L)
    s = jnp.where(valid[None, None, :, None], s, NEG)
    m = jnp.max(s, axis=-1, keepdims=True)
    p = jnp.exp(s - m)
    den = jnp.sum(p, axis=-1, keepdims=True)
    o = jnp.einsum('bdnhqk,bdnkhe->bdnhqe', p, vw) / den
    lse = (m + jnp.log(den))[..., 0]
    o = o.transpose(0, 1, 2, 4, 3, 5).reshape(B, dilation, Lp, H, Dh)[:, :, :L]
    o = o.transpose(0, 2, 1, 3, 4).reshape(B, S, H, Dh)
    lse = lse.transpose(0, 1, 2, 4, 3).reshape(B, dilation, Lp, H)[:, :, :L]
    lse = lse.transpose(0, 2, 1, 3).reshape(B, S, H)
    return o, lse


def hyena_positional_features(L):
    bands = (HY_EMB - 1) // 2
    t = jnp.linspace(0.0, 1.0, L, dtype=F32)[:, None]
    w = 2.0 * math.pi * jnp.arange(L, dtype=F32)[:, None] / L
    f = jnp.linspace(1e-4, bands - 1, bands, dtype=F32)[None, :]
    return jnp.concatenate([t, jnp.cos(f * w), -jnp.sin(f * w)], axis=-1)


def hyena_filters(z, w1, b1, w2, b2, w3, b3, w4, freq):
    L = z.shape[0]
    fr = freq.astype(F32)
    act = lambda u: jnp.sin(fr * u)
    hh = act(z @ w1.astype(F32) + b1.astype(F32))
    hh = act(hh @ w2.astype(F32) + b2.astype(F32))
    hh = act(hh @ w3.astype(F32) + b3.astype(F32))
    h = (hh @ w4.astype(F32)).reshape(L, HY_ORDER, 2, HY_WIDTH)
    max_decay = math.log(HY_TARGET) / HY_FAST_DECAY
    min_decay = math.log(HY_TARGET) / HY_SLOW_DECAY
    deltas = jnp.linspace(min_decay, max_decay, HY_WIDTH, dtype=F32)
    t = jnp.linspace(0.0, 1.0, L, dtype=F32)[:, None]
    decay = jnp.exp(-t * jnp.abs(deltas)[None, :])
    h = h * decay[:, None, None, :]
    return h.transpose(1, 2, 0, 3)


def bidir_fftconv(u, h, bias):
    L = u.shape[1]
    n = 2 * L
    uf = u.astype(F32)
    ud = jnp.stack([uf, uf[:, ::-1]], axis=0)
    U = jnp.fft.rfft(ud, n=n, axis=2)
    Hf = jnp.fft.rfft(h, n=n, axis=1)[:, None]
    y = jnp.fft.irfft(U * Hf, n=n, axis=2)[:, :, :L]
    return y[0] + y[1][:, ::-1] + uf * bias.astype(F32)


def hyena_mixer(u, conv_w, conv_b, filters, bias):
    S = u.shape[1]
    pad = HY_SHORT // 2
    up = jnp.pad(u, ((0, 0), (pad, pad), (0, 0)))
    uc = sum(up[:, j:j + S] * conv_w[j] for j in range(HY_SHORT)) + conv_b
    parts = jnp.split(uc, HY_ORDER + 1, axis=-1)
    z = parts[0]
    for o in range(HY_ORDER):
        z = parts[o + 1].astype(F32) * bidir_fftconv(z, filters[o], bias[o])
    return z.astype(u.dtype)


def head_rmsnorm(t, g):
    tf = t.astype(F32)
    y = tf * lax.rsqrt(jnp.mean(tf * tf, axis=-1, keepdims=True) + EPS)
    return (y * g.astype(F32)).astype(t.dtype)


def mem_attention(q, mem_n, w_kv, gq, gk):
    B, S, _ = q.shape
    M = mem_n.shape[1]
    k, v = jnp.split(mem_n @ w_kv, 2, axis=-1)
    q = head_rmsnorm(q.reshape(B, S, MEM_HEADS, HEAD_DIM), gq).astype(F32)
    k = head_rmsnorm(k.reshape(B, M, MEM_HEADS, HEAD_DIM), gk).astype(F32)
    v = v.reshape(B, M, MEM_HEADS, HEAD_DIM).astype(F32)
    s = jnp.einsum('bshe,bmhe->bhsm', q, k) / math.sqrt(HEAD_DIM)
    p = jax.nn.softmax(s, axis=-1)
    o = jnp.einsum('bhsm,bmhe->bshe', p, v)
    return o.reshape(B, S, MEM_WIDTH)


def setup_inputs(seed: int = 0) -> dict:
    key = jax.random.key(seed)
    ks = iter(jax.random.split(key, 48))

    def nrm(shape, scale):
        return scale * jax.random.normal(next(ks), shape, jnp.float32)

    def gain(shape):
        return 1.0 + 0.02 * jax.random.normal(next(ks), shape, jnp.float32)

    Lr = DEPTH
    Hf = HY_FILTER_HIDDEN
    return {
        'x': nrm((BATCH, SEQ, D_MODEL), 1.0),
        'mem': nrm((BATCH, N_MEM, D_MODEL), 1.0),
        'g_ff1': gain((Lr, D_MODEL)),
        'w_ff1_in': nrm((Lr, D_MODEL, 2 * D_FF), D_MODEL ** -0.5),
        'w_ff1_out': nrm((Lr, D_FF, D_MODEL), D_FF ** -0.5),
        'g_mix': gain((Lr, D_MODEL)),
        'w_in': nrm((Lr, D_MODEL, IN_WIDTH), D_MODEL ** -0.5),
        'a_gq': gain((Lr, HEAD_DIM)),
        'a_gk': gain((Lr, HEAD_DIM)),
        'hy_conv_w': nrm((Lr, HY_SHORT, (HY_ORDER + 1) * HY_WIDTH), HY_SHORT ** -0.5),
        'hy_conv_b': nrm((Lr, (HY_ORDER + 1) * HY_WIDTH), 0.02),
        'hy_f_w1': nrm((Lr, HY_EMB, Hf), HY_EMB ** -0.5),
        'hy_f_b1': nrm((Lr, Hf), 0.02),
        'hy_f_w2': nrm((Lr, Hf, Hf), Hf ** -0.5),
        'hy_f_b2': nrm((Lr, Hf), 0.02),
        'hy_f_w3': nrm((Lr, Hf, Hf), Hf ** -0.5),
        'hy_f_b3': nrm((Lr, Hf), 0.02),
        'hy_f_w4': nrm((Lr, Hf, HY_ORDER * 2 * HY_WIDTH), 0.1 * Hf ** -0.5),
        'hy_f_freq': gain((Lr, Hf)),
        'hy_bias': nrm((Lr, HY_ORDER, HY_WIDTH), 0.1),
        'g_mem': gain((Lr, D_MODEL)),
        'w_mem_kv': nrm((Lr, D_MODEL, 2 * MEM_WIDTH), D_MODEL ** -0.5),
        'm_gq': gain((Lr, HEAD_DIM)),
        'm_gk': gain((Lr, HEAD_DIM)),
        'w_br_a': nrm((Lr, DSWA_OUT, D_MODEL), DSWA_OUT ** -0.5),
        'w_br_b': nrm((Lr, HY_WIDTH, D_MODEL), HY_WIDTH ** -0.5),
        'w_br_c': nrm((Lr, MEM_WIDTH, D_MODEL), MEM_WIDTH ** -0.5),
        'w_out': nrm((Lr, D_MODEL, D_MODEL), D_MODEL ** -0.5),
        'g_ff2': gain((Lr, D_MODEL)),
        'w_ff2_in': nrm((Lr, D_MODEL, 2 * D_FF), D_MODEL ** -0.5),
        'w_ff2_out': nrm((Lr, D_FF, D_MODEL), D_FF ** -0.5),
        'g_post': gain((Lr, D_MODEL)),
    }


def reference(x, mem, g_ff1, w_ff1_in, w_ff1_out, g_mix, w_in, a_gq, a_gk,
              hy_conv_w, hy_conv_b, hy_f_w1, hy_f_b1, hy_f_w2, hy_f_b2, hy_f_w3, hy_f_b3,
              hy_f_w4, hy_f_freq, hy_bias, g_mem, w_mem_kv, m_gq, m_gk,
              w_br_a, w_br_b, w_br_c, w_out, g_ff2, w_ff2_in, w_ff2_out, g_post):
    B, S, _ = x.shape
    cos, sin = rope_tables(S)
    hy_z = hyena_positional_features(S)
    for l in range(DEPTH):
        x = x + 0.5 * swiglu(rmsnorm(x, g_ff1[l]), w_ff1_in[l], w_ff1_out[l])

        h = rmsnorm(x, g_mix[l])
        proj = h @ w_in[l]
        a_q, a_k, a_v, hy_u, m_q, gate_logits = jnp.split(proj, IN_SPLITS, axis=-1)

        a_q = partial_rope(head_rmsnorm(a_q.reshape(B, S, DSWA_HEADS, HEAD_DIM), a_gq[l]), cos, sin)
        a_k = partial_rope(head_rmsnorm(a_k.reshape(B, S, DSWA_HEADS, HEAD_DIM), a_gk[l]), cos, sin)
        a_v = a_v.reshape(B, S, DSWA_HEADS, HEAD_DIM)
        outs, lses = [], []
        for g, (win, dil) in enumerate(DSWA_GROUPS):
            sl = slice(g * DSWA_HEADS_PER_GROUP, (g + 1) * DSWA_HEADS_PER_GROUP)
            o, lse = dilated_window_attn(a_q[:, :, sl], a_k[:, :, sl], a_v[:, :, sl], win, dil)
            outs.append(o)
            lses.append(lse)
        alpha = jax.nn.softmax(jnp.stack(lses, axis=0), axis=0)[..., None]
        y_a = jnp.sum(alpha * jnp.stack(outs, axis=0), axis=0).reshape(B, S, DSWA_OUT).astype(x.dtype)

        filt = hyena_filters(hy_z, hy_f_w1[l], hy_f_b1[l], hy_f_w2[l], hy_f_b2[l],
                             hy_f_w3[l], hy_f_b3[l], hy_f_w4[l], hy_f_freq[l])
        y_b = hyena_mixer(hy_u, hy_conv_w[l], hy_conv_b[l], filt, hy_bias[l])

        y_c = mem_attention(m_q, rmsnorm(mem, g_mem[l]), w_mem_kv[l], m_gq[l], m_gk[l]).astype(x.dtype)

        ga, gb, gc = jnp.split(jax.nn.sigmoid(gate_logits.astype(F32)), N_BRANCH, axis=-1)
        merged = ga * (y_a @ w_br_a[l]) + gb * (y_b @ w_br_b[l]) + gc * (y_c @ w_br_c[l])
        x = x + merged.astype(x.dtype) @ w_out[l]

        x = x + 0.5 * swiglu(rmsnorm(x, g_ff2[l]), w_ff2_in[l], w_ff2_out[l])
        x = rmsnorm(x, g_post[l])
    return x
```

```cpp
#include <hip/hip_runtime.h>
#include <hip/hip_cooperative_groups.h>
#include <cstdio>
#include <cstdint>
namespace cg = cooperative_groups;
#ifndef MK_N_LAUNCHES
#define MK_N_LAUNCHES 1
#endif
#ifndef GEMM_ALIGN
#define GEMM_ALIGN true
#endif
#ifndef GEMM_SP2
#define GEMM_SP2 true
#endif
#ifndef RESID_ALIGN
#define RESID_ALIGN true
#endif
#define DUP_MASK 0x00

namespace pg8 {
#define PG8_LAS __attribute__((address_space(3)))
typedef unsigned short bf16_t;
typedef short bf16x8 __attribute__((ext_vector_type(8)));
typedef float f32x4 __attribute__((ext_vector_type(4)));
typedef unsigned u32x4 __attribute__((ext_vector_type(4)));
constexpr int BM = 256, BK = 64, HALF = 128, HTB = HALF * BK * 2  , STAGE_BYTES = 8 * HTB, NXCD = 8, WGM = 8;

__host__ __device__ __forceinline__ int lds_byte(int r, int c) { const int st = (r >> 4) * 2 + (c >> 5), rr = r & 15, cc = c & 31, ob = rr * 64 + cc * 2; return st * 1024 + (ob ^ (((ob >> 9) & 1) << 5)); }
__host__ __device__ __forceinline__ void stage_rc(int b, int& R, int& C) { const int st = b / 1024, sb = b % 1024, swz = sb ^ (((sb >> 9) & 1) << 5); R = (st >> 1) * 16 + swz / 64; C = (st & 1) * 32 + (swz % 64) / 2; }
__host__ __device__ __forceinline__ int perm32(int rho) { const int n = rho >> 4, i = rho & 15; return 8 * (i >> 2) + 4 * n + (i & 3); }

struct Unit { int pm, pn, ui; };
struct Gemm { const bf16_t* A; const bf16_t* Bt; int M, N, K, lda, ldb; };

struct StaticOrder {
    int nM, nN, nwg, G, c;
    __host__ __device__ void init(int M, int N, int G_, int c_) { nM = M / BM; nN = N / BM; nwg = nM * nN; G = G_; c = c_; }
    __host__ __device__ bool next(int i, Unit& u) const {
        const long L = (long)i * G + c; if (L >= nwg) return false;
        int wgid = (int)L; { const int q = nwg / NXCD, r = nwg % NXCD, xcd = wgid % NXCD, off = wgid / NXCD; wgid = (xcd < r ? xcd * (q + 1) : r * (q + 1) + (xcd - r) * q) + off; }
        const int nig = WGM * nN, gid = wgid / nig, fm = gid * WGM, gsz = (nM - fm) < WGM ? (nM - fm) : WGM;
        u.pm = fm + ((wgid % nig) % gsz); u.pn = (wgid % nig) / gsz; u.ui = i; return true;
    }
    __device__ __forceinline__ void a_ready(const Unit&) const {}
    __device__ __forceinline__ void done(const Unit&) const {}
};
__device__ __forceinline__ unsigned cvt_pk_bf16(float lo, float hi) { unsigned r; asm volatile("v_cvt_pk_bf16_f32 %0, %1, %2" : "=v"(r) : "v"(lo), "v"(hi)); return r; }
typedef float f32x2 __attribute__((ext_vector_type(2)));
typedef unsigned u32x2 __attribute__((ext_vector_type(2)));
__device__ __forceinline__ float rinv_of(const PG8_LAS float* rtab, const Unit& u, int rt) { return rtab[u.ui * BM + rt]; }
__device__ __forceinline__ float sigm(float v) { return __builtin_amdgcn_rcpf(1.0f + __builtin_amdgcn_exp2f(-1.4426950408889634f * v)); }
__device__ __forceinline__ float bf_lo(unsigned w) { return __builtin_bit_cast(float, w << 16); }
__device__ __forceinline__ float bf_hi(unsigned w) { return __builtin_bit_cast(float, w & 0xffff0000u); }
struct EpiSwiGLU {
    static constexpr bool PERM = true, AFTER_DRAIN = false, HAS_MID = false; static constexpr int MID_T1 = -1, MID_T2 = -1;
    bf16_t* O; int ldc; const PG8_LAS float* ss;
    __device__ __forceinline__ void operator()(const f32x4 (&acc)[2][2][4][2], const Unit& u, int wr, int wc, int fr, int fq) const {
        const int row0 = u.pm * BM + wr * 64 + fr, col0 = u.pn * HALF + wc * 32 + 8 * fq;
#pragma unroll
        for (int ai = 0; ai < 2; ++ai)
#pragma unroll
            for (int m = 0; m < 4; ++m) { const int row = row0 + ai * HALF + m * 16; const float r = rinv_of(ss, u, wr * 64 + fr + ai * HALF + m * 16);
                float h[8];
#pragma unroll
                for (int n = 0; n < 2; ++n)
#pragma unroll
                    for (int j = 0; j < 4; ++j) { const float a = acc[ai][0][m][n][j] * r, b = acc[ai][1][m][n][j] * r; h[4 * n + j] = a * sigm(a) * b; }
                u32x4 w; w.x = cvt_pk_bf16(h[0], h[1]); w.y = cvt_pk_bf16(h[2], h[3]); w.z = cvt_pk_bf16(h[4], h[5]); w.w = cvt_pk_bf16(h[6], h[7]);
                *(u32x4*)(O + (size_t)row * ldc + col0) = w; }
    }
};
template <int ACT> struct EpiScale {
    static constexpr bool PERM = true, AFTER_DRAIN = false, HAS_MID = false; static constexpr int MID_T1 = -1, MID_T2 = -1;
    bf16_t* O; int ldc; const PG8_LAS float* ss;
    __device__ __forceinline__ void operator()(const f32x4 (&acc)[2][2][4][2], const Unit& u, int wr, int wc, int fr, int fq) const {
        const int row0 = u.pm * BM + wr * 64 + fr, col0 = u.pn * BM + wc * 32 + 8 * fq;
#pragma unroll
        for (int ai = 0; ai < 2; ++ai)
#pragma unroll
            for (int m = 0; m < 4; ++m) { const int row = row0 + ai * HALF + m * 16; const float r = rinv_of(ss, u, wr * 64 + fr + ai * HALF + m * 16);
#pragma unroll
                for (int bj = 0; bj < 2; ++bj) { float h[8];
#pragma unroll
                    for (int n = 0; n < 2; ++n)
#pragma unroll
                        for (int j = 0; j < 4; ++j) { const float v = acc[ai][bj][m][n][j] * r; h[4 * n + j] = ACT ? sigm(v) : v; }
                    u32x4 w; w.x = cvt_pk_bf16(h[0], h[1]); w.y = cvt_pk_bf16(h[2], h[3]); w.z = cvt_pk_bf16(h[4], h[5]); w.w = cvt_pk_bf16(h[6], h[7]);
                    *(u32x4*)(O + (size_t)row * ldc + col0 + bj * HALF) = w; } }
    }
};
struct EpiGate8 {
    static constexpr bool PERM = true, AFTER_DRAIN = false, HAS_MID = false; static constexpr int MID_T1 = -1, MID_T2 = -1;
    unsigned char* Gq; int ldg; const PG8_LAS float* ss;
    __device__ __forceinline__ void operator()(const f32x4 (&acc)[2][2][4][2], const Unit& u, int wr, int wc, int fr, int fq) const {
        const int row0 = u.pm * BM + wr * 64 + fr, col0 = u.pn * BM + wc * 32 + 8 * fq;
#pragma unroll
        for (int ai = 0; ai < 2; ++ai)
#pragma unroll
            for (int m = 0; m < 4; ++m) { const int row = row0 + ai * HALF + m * 16; const float r = rinv_of(ss, u, wr * 64 + fr + ai * HALF + m * 16);
#pragma unroll
                for (int bj = 0; bj < 2; ++bj) { unsigned q[8];
#pragma unroll
                    for (int n = 0; n < 2; ++n)
#pragma unroll
                        for (int j = 0; j < 4; ++j) { const float g = sigm(acc[ai][bj][m][n][j] * r) * 255.0f + 0.5f; unsigned qi = (unsigned)g; qi = qi < 1u ? 1u : (qi > 255u ? 255u : qi); q[4 * n + j] = qi; }
                    u32x2 w; w.x = q[0] | (q[1] << 8) | (q[2] << 16) | (q[3] << 24); w.y = q[4] | (q[5] << 8) | (q[6] << 16) | (q[7] << 24);
                    *(u32x2*)(Gq + (size_t)row * ldg + col0 + bj * HALF) = w; } }
    }
};
struct EpiMergeCat {
    static constexpr bool PERM = true, AFTER_DRAIN = false, HAS_MID = true; static constexpr int MID_T1 = 4, MID_T2 = 16;
    const unsigned char* Gq; bf16_t* Mg; int ldg, ldm;
    __device__ __forceinline__ static void unpack8(const u32x2 w, float (&f)[8]) {
        f[0] = (float)(w.x & 255u); f[1] = (float)((w.x >> 8) & 255u); f[2] = (float)((w.x >> 16) & 255u); f[3] = (float)(w.x >> 24);
        f[4] = (float)(w.y & 255u); f[5] = (float)((w.y >> 8) & 255u); f[6] = (float)((w.y >> 16) & 255u); f[7] = (float)(w.y >> 24); }
    __device__ __forceinline__ void mid(f32x4 (&acc)[2][2][4][2], const Unit& u, int t, int wr, int wc, int fr, int fq) const {
        const int row0 = u.pm * BM + wr * 64 + fr, col0 = u.pn * BM + wc * 32 + 8 * fq; const int seg = (t == MID_T1) ? 0 : 2048;
        const unsigned char* gp = Gq + (size_t)row0 * ldg + seg + col0;
#pragma unroll
        for (int ai = 0; ai < 2; ++ai)
#pragma unroll
            for (int mp = 0; mp < 2; ++mp) { u32x2 wn[2][2], wd[2][2];
#pragma unroll
                for (int mi = 0; mi < 2; ++mi)
#pragma unroll
                    for (int bj = 0; bj < 2; ++bj) { const unsigned char* p = gp + (size_t)(ai * HALF + (2 * mp + mi) * 16) * ldg + bj * HALF; wn[mi][bj] = *(const u32x2*)p; wd[mi][bj] = *(const u32x2*)(p + 2048); }
#pragma unroll
                for (int mi = 0; mi < 2; ++mi)
#pragma unroll
                    for (int bj = 0; bj < 2; ++bj)
#pragma unroll
                        for (int n = 0; n < 2; ++n) { const unsigned a_ = n ? wn[mi][bj].y : wn[mi][bj].x, d_ = n ? wd[mi][bj].y : wd[mi][bj].x; f32x4& c = acc[ai][bj][2 * mp + mi][n];
                            c[0] *= (float)(a_ & 255u) * __builtin_amdgcn_rcpf((float)(d_ & 255u)); c[1] *= (float)((a_ >> 8) & 255u) * __builtin_amdgcn_rcpf((float)((d_ >> 8) & 255u));
                            c[2] *= (float)((a_ >> 16) & 255u) * __builtin_amdgcn_rcpf((float)((d_ >> 16) & 255u)); c[3] *= (float)(a_ >> 24) * __builtin_amdgcn_rcpf((float)(d_ >> 24)); }
                asm volatile("" ::: "memory"); }
    }
    __device__ __forceinline__ void operator()(const f32x4 (&acc)[2][2][4][2], const Unit& u, int wr, int wc, int fr, int fq) const {
        const int row0 = u.pm * BM + wr * 64 + fr, col0 = u.pn * BM + wc * 32 + 8 * fq;
        u32x2 wg[2][4][2];
#pragma unroll
        for (int ai = 0; ai < 2; ++ai)
#pragma unroll
            for (int m = 0; m < 4; ++m)
#pragma unroll
                for (int bj = 0; bj < 2; ++bj) wg[ai][m][bj] = *(const u32x2*)(Gq + (size_t)(row0 + ai * HALF + m * 16) * ldg + 4096 + col0 + bj * HALF);
        asm volatile("" ::: "memory");
#pragma unroll
        for (int ai = 0; ai < 2; ++ai)
#pragma unroll
            for (int m = 0; m < 4; ++m) { const int row = row0 + ai * HALF + m * 16; const size_t ro = (size_t)row * ldm + col0;
#pragma unroll
                for (int bj = 0; bj < 2; ++bj) { float fg[8], h[8]; unpack8(wg[ai][m][bj], fg);
#pragma unroll
                    for (int n = 0; n < 2; ++n)
#pragma unroll
                        for (int j = 0; j < 4; ++j) h[4 * n + j] = acc[ai][bj][m][n][j] * (fg[4 * n + j] * (1.0f / 255.0f));
                    u32x4 w; w.x = cvt_pk_bf16(h[0], h[1]); w.y = cvt_pk_bf16(h[2], h[3]); w.z = cvt_pk_bf16(h[4], h[5]); w.w = cvt_pk_bf16(h[6], h[7]);
                    *(u32x4*)(Mg + ro + bj * HALF) = w; } }
    }
};
struct EpiResid {
    static constexpr bool PERM = true, AFTER_DRAIN = false, HAS_MID = false; static constexpr int MID_T1 = -1, MID_T2 = -1;
    bf16_t* xb; float* ssq; float scale; int ldc;
    __device__ __forceinline__ void operator()(const f32x4 (&acc)[2][2][4][2], const Unit& u, int wr, int wc, int fr, int fq) const {
        const int row0 = u.pm * BM + wr * 64 + fr, col0 = u.pn * BM + wc * 32 + 8 * fq;
#pragma unroll
        for (int ai = 0; ai < 2; ++ai) { u32x4 bb[4][2];
#pragma unroll
            for (int m = 0; m < 4; ++m)
#pragma unroll
                for (int bj = 0; bj < 2; ++bj) bb[m][bj] = *(const u32x4*)(xb + (size_t)(row0 + ai * HALF + m * 16) * ldc + col0 + bj * HALF);
            asm volatile("" ::: "memory");
#pragma unroll
            for (int m = 0; m < 4; ++m) { const int row = row0 + ai * HALF + m * 16; const size_t ro = (size_t)row * ldc + col0; float sq = 0.f;
#pragma unroll
                for (int bj = 0; bj < 2; ++bj) { const u32x4 b = bb[m][bj]; float h[8];
                    h[0] = bf_lo(b.x) + scale * acc[ai][bj][m][0][0]; h[1] = bf_hi(b.x) + scale * acc[ai][bj][m][0][1]; h[2] = bf_lo(b.y) + scale * acc[ai][bj][m][0][2]; h[3] = bf_hi(b.y) + scale * acc[ai][bj][m][0][3];
                    h[4] = bf_lo(b.z) + scale * acc[ai][bj][m][1][0]; h[5] = bf_hi(b.z) + scale * acc[ai][bj][m][1][1]; h[6] = bf_lo(b.w) + scale * acc[ai][bj][m][1][2]; h[7] = bf_hi(b.w) + scale * acc[ai][bj][m][1][3];
                    sq += (h[0] * h[0] + h[1] * h[1]) + (h[2] * h[2] + h[3] * h[3]) + (h[4] * h[4] + h[5] * h[5]) + (h[6] * h[6] + h[7] * h[7]);
                    u32x4 w; w.x = cvt_pk_bf16(h[0], h[1]); w.y = cvt_pk_bf16(h[2], h[3]); w.z = cvt_pk_bf16(h[4], h[5]); w.w = cvt_pk_bf16(h[6], h[7]);
                    *(u32x4*)(xb + ro + bj * HALF) = w; }
                sq += __shfl_xor(sq, 16); sq += __shfl_xor(sq, 32);
                if (fq == 0) __hip_atomic_fetch_add(ssq + row, sq, __ATOMIC_RELAXED, __HIP_MEMORY_SCOPE_AGENT); }
            asm volatile("" ::: "memory"); }
    }
};
template <class Epi, class Sched, bool ALIGN_EPI = false, bool SP2 = false>
__device__ __forceinline__ void gemm_phase(PG8_LAS unsigned char* lds, const Gemm g, const Sched& S, const Epi& E) {
    int tid_l = threadIdx.x; asm volatile("" : "+v"(tid_l));
    const int tid = tid_l, wid = __builtin_amdgcn_readfirstlane(tid >> 6), lane = tid & 63, wr = wid >> 2, wc = wid & 3, fr = lane & 15, fq = lane >> 4;
    const int K = g.K, nt = K / BK;
    unsigned voffA[2], voffB[2];
#pragma unroll
    for (int i = 0; i < 2; ++i) { int R, C; stage_rc(tid * 16 + i * 8192, R, C); const int Rb = Epi::PERM ? ((R & ~31) + perm32(R & 31)) : R;
        voffA[i] = (unsigned)(R * g.lda + C) * 2u; voffB[i] = (unsigned)(Rb * g.ldb + C) * 2u; }
    const size_t kstep = (size_t)(BK * 2);
    const size_t hstepA = (size_t)HALF * g.lda * 2, hstepB = (size_t)HALF * g.ldb * 2;
    const size_t tstepA = 2 * hstepA, tstepB = 2 * hstepB;
    const unsigned ldsw = (unsigned)wid * 1024u;
    const int aoff = lds_byte(wr * 64 + fr, fq * 8), boff = lds_byte(wc * 32 + fr, fq * 8);
#define PG8_SA(b, h) (((b) * 2 + (h)) * HTB)
#define PG8_SB(b, h) ((4 + (b) * 2 + (h)) * HTB)
#define PG8_STAGE(bufoff, gbase, voff) do { _Pragma("unroll") for (int _i = 0; _i < 2; ++_i) \
        __builtin_amdgcn_global_load_lds((const unsigned*)((const char*)(gbase) + (voff)[_i]), (PG8_LAS unsigned*)(lds + (bufoff) + ldsw + _i * 8192), 16, 0, 0); } while (0)
#define PG8_LDA(dst, b, h) do { _Pragma("unroll") for (int m = 0; m < 4; ++m) _Pragma("unroll") for (int k = 0; k < 2; ++k) dst[m][k] = *(const PG8_LAS bf16x8*)(lds + PG8_SA(b, h) + aoff + m * 2048 + k * 1024); } while (0)
#define PG8_LDB(dst, b, h) do { _Pragma("unroll") for (int n = 0; n < 2; ++n) _Pragma("unroll") for (int k = 0; k < 2; ++k) dst[n][k] = *(const PG8_LAS bf16x8*)(lds + PG8_SB(b, h) + boff + n * 2048 + k * 1024); } while (0)
#define PG8_MMA(ai, bj, At, Bt) do { __builtin_amdgcn_s_setprio(1); _Pragma("unroll") for (int m = 0; m < 4; ++m) _Pragma("unroll") for (int n = 0; n < 2; ++n) _Pragma("unroll") for (int k = 0; k < 2; ++k) \
        acc[ai][bj][m][n] = __builtin_amdgcn_mfma_f32_16x16x32_bf16(Bt[n][k], At[m][k], acc[ai][bj][m][n], 0, 0, 0); __builtin_amdgcn_s_setprio(0); } while (0)
#define PG8_WAIT_V(n) asm volatile("s_waitcnt vmcnt(" #n ")" ::: "memory")
#define PG8_WAIT_L(n) asm volatile("s_waitcnt lgkmcnt(" #n ")" ::: "memory")
#define PG8_BAR __builtin_amdgcn_s_barrier()
#define PG8_SCHED __builtin_amdgcn_sched_barrier(0)
    Unit cur, nxt; int ui = 0;
    if (!S.next(0, cur)) return;
    f32x4 acc[2][2][4][2];
#pragma unroll
    for (int a = 0; a < 2; ++a)
#pragma unroll
        for (int b = 0; b < 2; ++b)
#pragma unroll
            for (int m = 0; m < 4; ++m)
#pragma unroll
                for (int n = 0; n < 2; ++n) acc[a][b][m][n] = (f32x4){0.f, 0.f, 0.f, 0.f};
    bf16x8 At[4][2], B0[2][2], B1[2][2];
    const char* cA = (const char*)g.A + (size_t)cur.pm * tstepA; const char* cB = (const char*)g.Bt + (size_t)cur.pn * tstepB;
    S.a_ready(cur);
    if constexpr (SP2) {
        PG8_STAGE(PG8_SB(0, 0), cB, voffB); PG8_STAGE(PG8_SB(0, 1), cB + hstepB, voffB); PG8_STAGE(PG8_SA(0, 0), cA, voffA); PG8_STAGE(PG8_SA(0, 1), cA + hstepA, voffA);
        if (wr == 1) PG8_BAR;
        PG8_WAIT_V(2); PG8_BAR;
        PG8_STAGE(PG8_SB(1, 0), cB + kstep, voffB); PG8_STAGE(PG8_SA(1, 0), cA + kstep, voffA); PG8_STAGE(PG8_SB(1, 1), cB + hstepB + kstep, voffB);
        PG8_WAIT_V(6); PG8_BAR;
    } else {
        PG8_STAGE(PG8_SB(0, 0), cB, voffB); PG8_STAGE(PG8_SA(0, 0), cA, voffA); PG8_STAGE(PG8_SB(0, 1), cB + hstepB, voffB); PG8_STAGE(PG8_SA(0, 1), cA + hstepA, voffA);
        if (wr == 1) PG8_BAR;
        PG8_WAIT_V(4); PG8_BAR;
        PG8_STAGE(PG8_SB(1, 0), cB + kstep, voffB); PG8_STAGE(PG8_SA(1, 0), cA + kstep, voffA); PG8_STAGE(PG8_SB(1, 1), cB + hstepB + kstep, voffB);
        PG8_WAIT_V(6); PG8_BAR;
    }
    for (;;) {
        const bool has_next = S.next(ui + 1, nxt);
        const char* nA = has_next ? (const char*)g.A + (size_t)nxt.pm * tstepA : cA; const char* nB = has_next ? (const char*)g.Bt + (size_t)nxt.pn * tstepB : cB;
        for (int t = 0; t < nt; t += 2) {
            const bool last = (t == nt - 2);
            const char* a1 = cA + (size_t)(t + 1) * kstep;
            const char* a2 = last ? nA : cA + (size_t)(t + 2) * kstep; const char* b2 = last ? nB : cB + (size_t)(t + 2) * kstep;
            const char* a3 = a2 + kstep; const char* b3 = b2 + kstep;
            if (last && has_next) S.a_ready(nxt);
            if constexpr (Epi::HAS_MID) { if (t == Epi::MID_T1 || t == Epi::MID_T2) E.mid(acc, cur, t, wr, wc, fr, fq); }
            if constexpr (SP2) {
            PG8_LDB(B0, 0, 0); PG8_LDB(B1, 0, 1); PG8_SCHED; PG8_LDA(At, 0, 0); PG8_STAGE(PG8_SA(1, 1), a1 + hstepA, voffA);
            PG8_WAIT_V(8); PG8_WAIT_L(0); PG8_BAR; PG8_MMA(0, 0, At, B0); PG8_MMA(0, 1, At, B1); PG8_BAR; PG8_SCHED;
            PG8_LDA(At, 0, 1); PG8_STAGE(PG8_SB(0, 0), b2, voffB); PG8_STAGE(PG8_SB(0, 1), b2 + hstepB, voffB); PG8_STAGE(PG8_SA(0, 0), a2, voffA);
            PG8_WAIT_V(8); PG8_WAIT_L(0); PG8_BAR; PG8_MMA(1, 0, At, B0); PG8_MMA(1, 1, At, B1); PG8_BAR; PG8_SCHED;
            PG8_LDB(B0, 1, 0); PG8_LDB(B1, 1, 1); PG8_SCHED; PG8_LDA(At, 1, 0); PG8_STAGE(PG8_SA(0, 1), a2 + hstepA, voffA);
            PG8_WAIT_V(8); PG8_WAIT_L(0); PG8_BAR; PG8_MMA(0, 0, At, B0); PG8_MMA(0, 1, At, B1); PG8_BAR; PG8_SCHED;
            PG8_LDA(At, 1, 1); PG8_STAGE(PG8_SB(1, 0), b3, voffB); PG8_STAGE(PG8_SB(1, 1), b3 + hstepB, voffB); PG8_STAGE(PG8_SA(1, 0), a3, voffA);
            PG8_WAIT_V(8); PG8_WAIT_L(0); PG8_BAR; PG8_MMA(1, 0, At, B0); PG8_MMA(1, 1, At, B1); PG8_BAR; PG8_SCHED;
            } else {
            PG8_LDB(B0, 0, 0); PG8_SCHED; PG8_LDA(At, 0, 0); PG8_STAGE(PG8_SA(1, 1), a1 + hstepA, voffA);
            PG8_WAIT_L(8); PG8_BAR; PG8_WAIT_L(0); PG8_MMA(0, 0, At, B0); PG8_BAR; PG8_SCHED;
            PG8_LDB(B1, 0, 1); PG8_STAGE(PG8_SB(0, 0), b2, voffB);
            PG8_BAR; PG8_WAIT_L(0); PG8_MMA(0, 1, At, B1); PG8_BAR;
            PG8_LDA(At, 0, 1); PG8_STAGE(PG8_SA(0, 0), a2, voffA);
            PG8_BAR; PG8_WAIT_L(0); PG8_MMA(1, 0, At, B0); PG8_BAR; PG8_SCHED;
            PG8_STAGE(PG8_SB(0, 1), b2 + hstepB, voffB);
            PG8_WAIT_V(6); PG8_BAR; PG8_MMA(1, 1, At, B1); PG8_BAR;
            PG8_LDB(B0, 1, 0); PG8_SCHED; PG8_LDA(At, 1, 0); PG8_STAGE(PG8_SA(0, 1), a2 + hstepA, voffA);
            PG8_WAIT_L(8); PG8_BAR; PG8_WAIT_L(0); PG8_MMA(0, 0, At, B0); PG8_BAR; PG8_SCHED;
            PG8_LDB(B1, 1, 1); PG8_STAGE(PG8_SB(1, 0), b3, voffB);
            PG8_BAR; PG8_WAIT_L(0); PG8_MMA(0, 1, At, B1); PG8_BAR;
            PG8_LDA(At, 1, 1); PG8_STAGE(PG8_SA(1, 0), a3, voffA);
            PG8_BAR; PG8_WAIT_L(0); PG8_MMA(1, 0, At, B0); PG8_BAR; PG8_SCHED;
            PG8_STAGE(PG8_SB(1, 1), b3 + hstepB, voffB);
            PG8_WAIT_V(6); PG8_BAR; PG8_MMA(1, 1, At, B1); PG8_BAR;
            }
        }
        if constexpr (ALIGN_EPI) { if (wr == 0) PG8_BAR; }
        if constexpr (!Epi::AFTER_DRAIN) { E(acc, cur, wr, wc, fr, fq); S.done(cur); }
        if (!has_next) break;
#pragma unroll
        for (int a = 0; a < 2; ++a)
#pragma unroll
            for (int b = 0; b < 2; ++b)
#pragma unroll
                for (int m = 0; m < 4; ++m)
#pragma unroll
                    for (int n = 0; n < 2; ++n) acc[a][b][m][n] = (f32x4){0.f, 0.f, 0.f, 0.f};
        cur = nxt; cA = nA; cB = nB; ++ui;
        if constexpr (ALIGN_EPI) { if (wr == 1) PG8_BAR; }
    }
    PG8_WAIT_V(0);
    if constexpr (!ALIGN_EPI) { if (wr == 0) PG8_BAR; }
    PG8_BAR;
    if constexpr (Epi::AFTER_DRAIN) { E.fused(acc, cur, wr, wc, fr, fq, lds, wid, lane); S.done(cur); }
#undef PG8_SA
#undef PG8_SB
#undef PG8_STAGE
#undef PG8_LDA
#undef PG8_LDB
#undef PG8_MMA
#undef PG8_WAIT_V
#undef PG8_WAIT_L
#undef PG8_BAR
#undef PG8_SCHED
}
}

#define LAS __attribute__((address_space(3)))
typedef unsigned short bf16;
typedef unsigned v4u __attribute__((ext_vector_type(4)));
typedef unsigned v2u __attribute__((ext_vector_type(2)));
typedef float f32x4 __attribute__((ext_vector_type(4)));
typedef short bf16x8 __attribute__((ext_vector_type(8)));
constexpr int NWAVES = 8, NTHR = 512;
constexpr int BATCH = 8, SEQ = 2048, DM = 2048, T = BATCH * SEQ, FF = 5632, NMIX = 5120, NIN = 11264, HYW = 768;
constexpr size_t MiB = 1u << 20;
constexpr size_t WS_SS = 0;
constexpr size_t WS_CEN = 256 * 1024;
constexpr size_t WS_ROPE = 512 * 1024;
constexpr size_t WS_BAR = 320 * 1024;
constexpr size_t WS_HH3 = 1536 * 1024;
constexpr size_t WS_LSE = 1 * MiB;
constexpr int XP = 2112;
constexpr size_t WS_WFFIN = 2 * MiB;
constexpr size_t WS_WFFOUT = 48 * MiB;
constexpr size_t WS_WIN = 70 * MiB;
constexpr size_t WS_WBR = 116 * MiB;
constexpr size_t WS_WOUT = 122 * MiB;
constexpr size_t WS_WMKV = 131 * MiB;
constexpr size_t WS_XB = 136 * MiB;
constexpr size_t WS_MEMNB = 202 * MiB;
constexpr size_t WS_MK = 210 * MiB, WS_MV = 212 * MiB;
constexpr size_t WS_KC = 214 * MiB;
constexpr size_t WS_HV = 226 * MiB;
constexpr size_t WS_BIG = 274 * MiB;
constexpr size_t WS_ACT = WS_BIG;
constexpr size_t WS_PROJ = WS_BIG;
constexpr size_t WS_G = WS_BIG, WS_MG = WS_BIG + 96 * MiB;
constexpr size_t WS_YCAT = WS_BIG + 176 * MiB;
constexpr int YCP = 1536;
constexpr size_t WS_END = WS_BIG + 224 * MiB;
constexpr size_t OUT_OG = 0;
constexpr size_t OUT_HZ = 24 * MiB;
constexpr int LDS_BYTES = 147456;
constexpr int LDS_MISC = 147200;
constexpr int NPHASE = 12;

struct Args { const float* in[32]; float* out; unsigned char* ws; int ph_lo, ph_hi; };

#define LDS_WAIT() asm volatile("s_waitcnt lgkmcnt(0)" ::: "memory")
__device__ __forceinline__ unsigned f2bf(float f) { unsigned u = __builtin_bit_cast(unsigned, f); return (u + 0x7fffu + ((u >> 16) & 1u)) >> 16; }
__device__ __forceinline__ unsigned pk2(float lo, float hi) { return f2bf(lo) | (f2bf(hi) << 16); }
__device__ __forceinline__ float bflo(unsigned w) { return __builtin_bit_cast(float, w << 16); }
__device__ __forceinline__ float bfhi(unsigned w) { return __builtin_bit_cast(float, w & 0xffff0000u); }
__device__ __forceinline__ float bf1(unsigned short h) { return __builtin_bit_cast(float, (unsigned)h << 16); }
__device__ __forceinline__ float wave_sum(float v) {
#pragma unroll
    for (int o = 1; o < 64; o <<= 1) v += __shfl_xor(v, o);
    return v;
}
__device__ __forceinline__ float fsin(float x) { return __builtin_amdgcn_sinf(__builtin_amdgcn_fractf(x * 0.15915494309189535f)); }
__device__ __forceinline__ float fcos(float x) { return __builtin_amdgcn_cosf(__builtin_amdgcn_fractf(x * 0.15915494309189535f)); }
__device__ __forceinline__ float fexp(float x) { return __builtin_amdgcn_exp2f(x * 1.4426950408889634f); }

#define XB_TMO      128
#define XB_XCNT(j)  (256  + 64 * (j))
#define XB_XSUB(j)  (1280 + 64 * (j))
#define XB_XGEN(j)  (2304 + 64 * (j))
#define XB_TOP      3328
#define XB_TOPGEN   3392
#define XCD_BAR_WORDS 3456
#define XB_SPIN_CAP (1u << 18)

__device__ __forceinline__ unsigned xb_ld(unsigned* p)              { return __hip_atomic_load(p, __ATOMIC_RELAXED, __HIP_MEMORY_SCOPE_AGENT); }
__device__ __forceinline__ unsigned xb_add(unsigned* p, unsigned v) { return __hip_atomic_fetch_add(p, v, __ATOMIC_RELAXED, __HIP_MEMORY_SCOPE_AGENT); }
__device__ __forceinline__ unsigned xb_xcc_id() { return (unsigned)__builtin_amdgcn_s_getreg((3 << 11) | 20) & 0xFu; }
#define XB_SPIN(cond, bar) do { unsigned _sp = 0; while (cond) { __builtin_amdgcn_s_sleep(1); \
    if ((++_sp & 255u) == 0u) { if (xb_ld(&(bar)[XB_TMO])) break; if (_sp > XB_SPIN_CAP) { atomicAdd(&(bar)[XB_TMO], 1u); break; } } } } while (0)

struct XcdBarrier {
    unsigned* bar; unsigned x;
    volatile LAS unsigned* st;
};

__device__ __forceinline__ XcdBarrier xcd_barrier_post(unsigned* bar, volatile LAS unsigned* st) {
    XcdBarrier b; b.bar = bar; b.x = xb_xcc_id(); b.st = st;
    if (threadIdx.x == 0) (void)xb_add(&bar[XB_XCNT(b.x)], 1u);
    return b;
}
__device__ __forceinline__ void xcd_barrier_complete(unsigned* bar, unsigned x, unsigned& nloc, unsigned& nx) {
    const unsigned G = gridDim.x * gridDim.y * gridDim.z;
    unsigned sum, cnt, mine, sp = 0u;
    for (;;) {
        sum = 0u; cnt = 0u; mine = 0u;
#pragma unroll
        for (unsigned j = 0; j < 16; ++j) { const unsigned c = xb_ld(&bar[XB_XCNT(j)]); sum += c; cnt += (c > 0u) ? 1u : 0u; mine = (j == x) ? c : mine; }
        if (sum == G) break;
        __builtin_amdgcn_s_sleep(1);
        if ((++sp & 255u) == 0u) { if (xb_ld(&bar[XB_TMO])) break; if (sp > XB_SPIN_CAP) { atomicAdd(&bar[XB_TMO], 1u); break; } }
    }
    nloc = mine > 0u ? mine : 1u; nx = cnt > 0u ? cnt : 1u;
}

__device__ __forceinline__ void xcd_barrier(const XcdBarrier& b) {
    asm volatile("s_waitcnt vmcnt(0)" ::: "memory");
    __syncthreads();
    if (threadIdx.x == 0) {
        unsigned* bar = b.bar;
        __builtin_amdgcn_s_waitcnt(0);
        unsigned nloc = b.st[0], nx = b.st[1];
        if (nloc == 0u) { xcd_barrier_complete(bar, b.x, nloc, nx); b.st[0] = nloc; b.st[1] = nx; }
        const unsigned old = xb_add(&bar[XB_XSUB(b.x)], 1u);
        const unsigned gen = old / nloc;
        if (old + 1u == (gen + 1u) * nloc) {
            __builtin_amdgcn_fence(__ATOMIC_RELEASE, "agent");
            asm volatile("s_waitcnt vmcnt(0)" ::: "memory");
            const unsigned og = xb_add(&bar[XB_TOP], 1u);
            const unsigned tg = og / nx;
            if (og + 1u == (tg + 1u) * nx) xb_add(&bar[XB_TOPGEN], 1u);
            else XB_SPIN(xb_ld(&bar[XB_TOPGEN]) == tg, bar);
            __builtin_amdgcn_fence(__ATOMIC_ACQUIRE, "agent");
            xb_add(&bar[XB_XGEN(b.x)], 1u);
            asm volatile("s_waitcnt vmcnt(0)" ::: "memory");
        } else {
            XB_SPIN(xb_ld(&bar[XB_XGEN(b.x)]) == gen, bar);
            __builtin_amdgcn_fence(__ATOMIC_ACQUIRE, "agent");
            asm volatile("s_waitcnt vmcnt(0)" ::: "memory");
        }
    }
    __syncthreads();
}

__device__ __forceinline__ void cvt_load(const float* __restrict__ W, int N, int nblk, int item, int lane, f32x4 (&v)[8]) {
    const int kb = item / nblk, nb = item % nblk, k0 = 64 * kb, n0 = 32 * nb;
#pragma unroll
    for (int i = 0; i < 8; ++i) v[i] = *(const f32x4*)(W + (size_t)(k0 + 8 * i + (lane >> 3)) * N + n0 + 4 * (lane & 7));
}
__device__ __forceinline__ void cvt_store(const f32x4 (&v)[8], int ldw, int nblk, const float* __restrict__ g, bf16* WT, int perm, LAS float* scr, int item, int lane) {
    const int kb = item / nblk, nb = item % nblk, k0 = 64 * kb, n0 = 32 * nb;
#pragma unroll
    for (int i = 0; i < 8; ++i) { const int kk = 8 * i + (lane >> 3); const float gk = g ? g[k0 + kk] : 1.0f; LAS float* d = scr + kk * 33 + 4 * (lane & 7);
        d[0] = v[i].x * gk; d[1] = v[i].y * gk; d[2] = v[i].z * gk; d[3] = v[i].w * gk; }
    LDS_WAIT(); asm volatile("" ::: "memory");
    int d0 = n0;
    if (perm) { const int isb = n0 >= FF ? 1 : 0, j = n0 - isb * FF; d0 = 256 * (j >> 7) + (j & 127) + 128 * isb; }
    const int c = lane & 7;
#pragma unroll
    for (int j = 0; j < 4; ++j) { const int n = (lane >> 3) + 8 * j; const LAS float* s = scr + (8 * c) * 33 + n;
        v4u o; o.x = pk2(s[0 * 33], s[1 * 33]); o.y = pk2(s[2 * 33], s[3 * 33]); o.z = pk2(s[4 * 33], s[5 * 33]); o.w = pk2(s[6 * 33], s[7 * 33]);
        *(v4u*)(WT + (size_t)(d0 + n) * ldw + k0 + 8 * c) = o; }
    LDS_WAIT(); asm volatile("" ::: "memory");
}
__device__ __forceinline__ void cvt_matrix(const float* W, int K, int N, const float* g, bf16* WT, int ldw, int perm, LAS float* scr, int gw, int NGW, int lane) {
    const int nblk = N / 32, nitems = (K / 64) * nblk;
    int it = gw; f32x4 v[8], vn[8];
    if (it < nitems) cvt_load(W, N, nblk, it, lane, v);
    while (it < nitems) { const int nit = it + NGW;
        if (nit < nitems) cvt_load(W, N, nblk, nit, lane, vn);
        cvt_store(v, ldw, nblk, g, WT, perm, scr, it, lane);
#pragma unroll
        for (int i = 0; i < 8; ++i) v[i] = vn[i];
        it = nit; }
}
struct CvtSel { const float* W; const float* g; bf16* WT; int N, nblk, ldw, perm, local; };
__device__ __forceinline__ CvtSel cvt_select(const Args& a, int gi) {
    unsigned char* ws = a.ws; CvtSel c;
    if (gi < 11264)      { c.W = a.in[3];  c.g = a.in[2];  c.WT = (bf16*)(ws + WS_WFFIN);      c.N = NIN;  c.ldw = XP;  c.perm = 1; c.local = gi; }
    else if (gi < 16896) { c.W = a.in[4];  c.g = nullptr;  c.WT = (bf16*)(ws + WS_WFFOUT);     c.N = DM;   c.ldw = FF;  c.perm = 0; c.local = gi - 11264; }
    else if (gi < 28160) { c.W = a.in[6];  c.g = a.in[5];  c.WT = (bf16*)(ws + WS_WIN);        c.N = NIN;  c.ldw = XP;  c.perm = 0; c.local = gi - 16896; }
    else if (gi < 29184) { c.W = a.in[21]; c.g = nullptr;  c.WT = (bf16*)(ws + WS_WMKV);       c.N = 1024; c.ldw = XP;  c.perm = 0; c.local = gi - 28160; }
    else if (gi < 29440) { c.W = a.in[24]; c.g = nullptr;  c.WT = (bf16*)(ws + WS_WBR);        c.N = DM;   c.ldw = YCP; c.perm = 0; c.local = gi - 29184; }
    else if (gi < 30208) { c.W = a.in[25]; c.g = nullptr;  c.WT = (bf16*)(ws + WS_WBR) + 256;  c.N = DM;   c.ldw = YCP; c.perm = 0; c.local = gi - 29440; }
    else if (gi < 30720) { c.W = a.in[26]; c.g = nullptr;  c.WT = (bf16*)(ws + WS_WBR) + 1024; c.N = DM;   c.ldw = YCP; c.perm = 0; c.local = gi - 30208; }
    else                 { c.W = a.in[27]; c.g = nullptr;  c.WT = (bf16*)(ws + WS_WOUT);       c.N = DM;   c.ldw = XP;  c.perm = 0; c.local = gi - 30720; }
    c.nblk = c.N / 32; return c;
}
__device__ __forceinline__ void cvt_all(const Args& a, LAS float* scr, int gw, int NGW, int lane) {
    constexpr int NITEMS = 32768;
    int gi = gw; f32x4 v[8], vn[8];
    if (gi < NITEMS) { const CvtSel c = cvt_select(a, gi); cvt_load(c.W, c.N, c.nblk, c.local, lane, v); }
    while (gi < NITEMS) { const int ng = gi + NGW;
        if (ng < NITEMS) { const CvtSel cn = cvt_select(a, ng); cvt_load(cn.W, cn.N, cn.nblk, cn.local, lane, vn); }
        const CvtSel c = cvt_select(a, gi); cvt_store(v, c.ldw, c.nblk, c.g, c.WT, c.perm, scr, c.local, lane);
#pragma unroll
        for (int i = 0; i < 8; ++i) v[i] = vn[i];
        gi = ng; }
}
#define FMAC(acc_, a_, b_) asm("v_fmac_f32 %0, %1, %2" : "+v"(acc_) : "v"(a_), "v"(b_))
template <int NIN4, int NIN> __device__ __forceinline__ void hy_dense8(const LAS float* hin, const float* __restrict__ W, int ldw, int col, int row0, float (&acc)[8]) {
    float wr[NIN4 * 4];
    const float* __restrict__ wp = W + col;
#pragma unroll
    for (int i = 0; i < NIN4 * 4; ++i) { wr[i] = i < NIN ? wp[0] : 0.f; wp += ldw; }
#pragma unroll
    for (int t = 0; t < 8; ++t) { float s = 0.f;
#pragma unroll
        for (int i4 = 0; i4 < NIN4; ++i4) { const f32x4 h = *(const LAS f32x4*)(hin + (row0 + t) * 64 + 4 * i4); FMAC(s, h.x, wr[4 * i4]); FMAC(s, h.y, wr[4 * i4 + 1]); FMAC(s, h.z, wr[4 * i4 + 2]); FMAC(s, h.w, wr[4 * i4 + 3]); }
        acc[t] = s; }
}
__device__ __forceinline__ void hy_mlp_item(const Args& a, LAS float* buf, int item, int lane) {
    LAS float* A = buf; LAS float* B = buf + 512; const int t0 = item * 8, tl = lane & 7, t = t0 + tl;
    const float tf = (float)t * (1.0f / 2047.0f), wt = (6.283185307179586f * (float)t) * (1.0f / 2048.0f);
#pragma unroll
    for (int k = 0; k < 5; ++k) { const int f = (lane >> 3) + 8 * k; float v = 0.f;
        if (f == 0) v = tf; else if (f <= 16) v = fcos((1e-4f + (float)(f - 1) * ((15.0f - 1e-4f) / 15.0f)) * wt); else if (f <= 32) v = -fsin((1e-4f + (float)(f - 17) * ((15.0f - 1e-4f) / 15.0f)) * wt);
        A[tl * 64 + f] = v; }
    LDS_WAIT(); asm volatile("" ::: "memory");
    const float fr = a.in[18][lane]; float acc[8];
    const float* w1 = a.in[11]; const float* w2 = a.in[13]; const float* w3 = a.in[15];
    asm volatile("" : "+s"(w1), "+s"(w2), "+s"(w3));
    hy_dense8<9, 33>(A, w1, 64, lane, 0, acc);
    { const float bs = a.in[12][lane];
#pragma unroll
      for (int q = 0; q < 8; ++q) B[q * 64 + lane] = fsin(fr * (acc[q] + bs)); }
    LDS_WAIT(); asm volatile("" ::: "memory");
    hy_dense8<16, 64>(B, w2, 64, lane, 0, acc);
    { const float bs = a.in[14][lane];
#pragma unroll
      for (int q = 0; q < 8; ++q) A[q * 64 + lane] = fsin(fr * (acc[q] + bs)); }
    LDS_WAIT(); asm volatile("" ::: "memory");
    hy_dense8<16, 64>(A, w3, 64, lane, 0, acc);
    { const float bs = a.in[16][lane]; float* hh3 = (float*)(a.ws + WS_HH3);
#pragma unroll
      for (int q = 0; q < 8; ++q) hh3[(size_t)(t0 + q) * 64 + lane] = fsin(fr * (acc[q] + bs)); }
    LDS_WAIT(); asm volatile("" ::: "memory");
}
__device__ __forceinline__ void hy_l4_item(const Args& a, LAS float* hb, int item, int lane) {
    const int cg = item % 48, tb = item / 48, t0 = tb * 64, col = cg * 64 + lane;
    const float* hh3 = (const float*)(a.ws + WS_HH3);
#pragma unroll 4
    for (int it = 0; it < 17; ++it) { const int row = it * 4 + (lane >> 4);
        if (row < 65) { const int tt = t0 + row; f32x4 v = {0.f, 0.f, 0.f, 0.f}; if (tt < SEQ) v = *(const f32x4*)(hh3 + (size_t)tt * 64 + 4 * (lane & 15)); *(LAS f32x4*)(hb + row * 64 + 4 * (lane & 15)) = v; } }
    LDS_WAIT(); asm volatile("" ::: "memory");
    const int o = cg / 24, dir = (cg / 12) & 1, c = col % 768;
    const float ad = __builtin_fabsf(-3.0701134573253946f + (float)c * ((-15.350567286626973f + 3.0701134573253946f) / 767.0f));
    float* cen = (float*)(a.ws + WS_CEN); bf16* kcr = (bf16*)(a.ws + WS_KC) + ((size_t)(o * 768 + c)) * 4096;
    float acc[8];
#pragma unroll 1
    for (int blk = 0; blk < 8; ++blk) {
        hy_dense8<16, 64>(hb, a.in[17], 3072, col, 8 * blk + dir, acc);
        float val[8];
#pragma unroll
        for (int e = 0; e < 8; ++e) { const int tt = t0 + 8 * blk + e + dir; val[e] = acc[e] * fexp(-((float)tt * (1.0f / 2047.0f)) * ad); }
        v4u w;
        if (dir == 0) { w.x = pk2(val[0], val[1]); w.y = pk2(val[2], val[3]); w.z = pk2(val[4], val[5]); w.w = pk2(val[6], val[7]); *(v4u*)(kcr + 2048 + t0 + 8 * blk) = w; if (t0 == 0 && blk == 0) cen[(o * 2) * 768 + c] = val[0]; }
        else { w.x = pk2(val[7], val[6]); w.y = pk2(val[5], val[4]); w.z = pk2(val[3], val[2]); w.w = pk2(val[1], val[0]); *(v4u*)(kcr + 2048 - (t0 + 8 * blk + 8)) = w; }
    }
    if (dir == 1 && t0 == 0) { hy_dense8<16, 64>(hb, a.in[17], 3072, col, 0, acc); cen[(o * 2 + 1) * 768 + c] = acc[0]; }
    LDS_WAIT(); asm volatile("" ::: "memory");
}
__device__ __forceinline__ void phase0(const Args& a, LAS unsigned char* lds, int tid, int lane, int wave, int bid, int G) {
    unsigned char* ws = a.ws;
    LAS float* scr = (LAS float*)(lds + wave * 16384);
    const int gw = bid * NWAVES + wave, NGW = G * NWAVES;
    cvt_all(a, scr, gw, NGW, lane);
    { const float* x = a.in[0]; bf16* xb = (bf16*)(ws + WS_XB); float* ss = (float*)(ws + WS_SS);
      int row = gw; f32x4 v[8], vn[8];
      if (row < T) {
#pragma unroll
          for (int j = 0; j < 8; ++j) v[j] = ((const f32x4*)(x + (size_t)row * DM))[lane + 64 * j]; }
      while (row < T) { const int nrow = row + NGW;
          if (nrow < T) {
#pragma unroll
              for (int j = 0; j < 8; ++j) vn[j] = ((const f32x4*)(x + (size_t)nrow * DM))[lane + 64 * j]; }
          v2u* xo = (v2u*)(xb + (size_t)row * XP) + lane; float s = 0.f;
#pragma unroll
          for (int j = 0; j < 8; ++j) { s += (v[j].x * v[j].x + v[j].y * v[j].y) + (v[j].z * v[j].z + v[j].w * v[j].w); v2u o; o.x = pk2(v[j].x, v[j].y); o.y = pk2(v[j].z, v[j].w); xo[64 * j] = o; }
          s = wave_sum(s); if (lane == 0) ss[row] = s;
#pragma unroll
          for (int j = 0; j < 8; ++j) v[j] = vn[j];
          row = nrow; } }
    { const float* mem = a.in[1]; const float* gm = a.in[20]; bf16* mb = (bf16*)(ws + WS_MEMNB);
      for (int row = gw; row < 2048; row += NGW) { const f32x4* xr = (const f32x4*)(mem + (size_t)row * DM) + lane; v2u* xo = (v2u*)(mb + (size_t)row * DM) + lane; f32x4 v[8]; float s = 0.f;
#pragma unroll
          for (int j = 0; j < 8; ++j) { v[j] = xr[64 * j]; s += (v[j].x * v[j].x + v[j].y * v[j].y) + (v[j].z * v[j].z + v[j].w * v[j].w); }
          const float r = __builtin_amdgcn_rsqf(wave_sum(s) * (1.0f / 2048.0f) + 1e-6f);
#pragma unroll
          for (int j = 0; j < 8; ++j) { const f32x4 gg = ((const f32x4*)gm)[lane + 64 * j]; v2u o; o.x = pk2(v[j].x * r * gg.x, v[j].y * r * gg.y); o.y = pk2(v[j].z * r * gg.z, v[j].w * r * gg.w); xo[64 * j] = o; } } }
    { float* ss = (float*)(ws + WS_SS);
      const int gt = bid * NTHR + tid, NGT = G * NTHR;
      for (int idx = gt; idx < 3 * T; idx += NGT) ss[T + idx] = 0.f; }
    for (int it = NGW - 1 - gw; it < 256; it += NGW) hy_mlp_item(a, scr, it, lane);
}

__device__ __forceinline__ void memkv_tile(const Args& a, LAS unsigned char* lds, int tile, int tid, int lane, int wave) {
    unsigned char* ws = a.ws;
    const int rb = tile >> 3, cb = tile & 7, rg = wave & 3, kh = wave >> 2, l15 = lane & 15, l4 = lane >> 4;
    const bf16* A = (const bf16*)(ws + WS_MEMNB) + (size_t)(rb * 64 + rg * 16 + l15) * DM + kh * 1024 + 8 * l4;
    const bf16* Bw = (const bf16*)(ws + WS_WMKV) + (size_t)(cb * 128 + l15) * XP + kh * 1024 + 8 * l4;
    f32x4 acc[8];
#pragma unroll
    for (int nt = 0; nt < 8; ++nt) acc[nt] = (f32x4){0.f, 0.f, 0.f, 0.f};
    bf16x8 af = *(const bf16x8*)A, bfr[8];
#pragma unroll
    for (int nt = 0; nt < 8; ++nt) bfr[nt] = *(const bf16x8*)(Bw + (size_t)nt * 16 * XP);
#pragma unroll 1
    for (int ks = 0; ks < 32; ++ks) { const int kn = ks < 31 ? ks + 1 : 31; const bf16x8 afn = *(const bf16x8*)(A + 32 * kn); bf16x8 bfn[8];
#pragma unroll
        for (int nt = 0; nt < 8; ++nt) bfn[nt] = *(const bf16x8*)(Bw + (size_t)nt * 16 * XP + 32 * kn);
#pragma unroll
        for (int nt = 0; nt < 8; ++nt) acc[nt] = __builtin_amdgcn_mfma_f32_16x16x32_bf16(bfr[nt], af, acc[nt], 0, 0, 0);
        af = afn;
#pragma unroll
        for (int nt = 0; nt < 8; ++nt) bfr[nt] = bfn[nt]; }
    LAS float* red = (LAS float*)lds;
    if (kh == 1) {
#pragma unroll
        for (int nt = 0; nt < 8; ++nt)
#pragma unroll
            for (int v = 0; v < 4; ++v) red[(rg * 32 + nt * 4 + v) * 64 + lane] = acc[nt][v]; }
    __syncthreads();
    if (kh == 0) {
#pragma unroll
        for (int nt = 0; nt < 8; ++nt)
#pragma unroll
            for (int v = 0; v < 4; ++v) acc[nt][v] += red[(rg * 32 + nt * 4 + v) * 64 + lane];
        const int R = rb * 64 + rg * 16 + l15, b = R >> 8, m = R & 255;
        if (cb < 4) { float s = 0.f;
#pragma unroll
            for (int nt = 0; nt < 8; ++nt) s += (acc[nt][0] * acc[nt][0] + acc[nt][1] * acc[nt][1]) + (acc[nt][2] * acc[nt][2] + acc[nt][3] * acc[nt][3]);
            s += __shfl_xor(s, 16); s += __shfl_xor(s, 32);
            const float r = __builtin_amdgcn_rsqf(s * (1.0f / 128.0f) + 1e-6f); const float* gk = a.in[23];
            bf16* mk = (bf16*)(ws + WS_MK) + ((size_t)((b * 4 + cb) * 256 + m)) * 128;
#pragma unroll
            for (int nt = 0; nt < 8; ++nt) { const int d = 16 * nt + 4 * l4; const f32x4 gg = *(const f32x4*)(gk + d); v2u o; o.x = pk2(acc[nt][0] * r * gg.x, acc[nt][1] * r * gg.y); o.y = pk2(acc[nt][2] * r * gg.z, acc[nt][3] * r * gg.w); *(v2u*)(mk + d) = o; }
        } else {
            bf16* mv = (bf16*)(ws + WS_MV) + ((size_t)((b * 4 + (cb - 4)) * 256 + m)) * 128;
#pragma unroll
            for (int nt = 0; nt < 8; ++nt) { const int d = 16 * nt + 4 * l4; v2u o; o.x = pk2(acc[nt][0], acc[nt][1]); o.y = pk2(acc[nt][2], acc[nt][3]); *(v2u*)(mv + d) = o; }
        }
    }
    __syncthreads();
}

__device__ __forceinline__ constexpr float rope_rf(int i) {
    constexpr float RF[16] = {1.591549367e-01f, 7.008652389e-02f, 3.086376376e-02f, 1.359137055e-02f, 5.985185504e-03f, 2.635675715e-03f, 1.160663669e-03f, 5.111175124e-04f,
                              2.250790858e-04f, 9.911730012e-05f, 4.364795313e-05f, 1.922110096e-05f, 8.464330676e-06f, 3.727408739e-06f, 1.641426365e-06f, 7.228293271e-07f};
    return RF[i];
}
template <bool ROPE> __device__ __forceinline__ void row_norm_store(v4u w0, v4u w1, const float* __restrict__ gain, int pos, float scale, LAS unsigned char* dst, int sub) {
    float f[16];
    f[0] = bflo(w0.x); f[1] = bfhi(w0.x); f[2] = bflo(w0.y); f[3] = bfhi(w0.y); f[4] = bflo(w0.z); f[5] = bfhi(w0.z); f[6] = bflo(w0.w); f[7] = bfhi(w0.w);
    f[8] = bflo(w1.x); f[9] = bfhi(w1.x); f[10] = bflo(w1.y); f[11] = bfhi(w1.y); f[12] = bflo(w1.z); f[13] = bfhi(w1.z); f[14] = bflo(w1.w); f[15] = bfhi(w1.w);
    float ss = 0.f;
#pragma unroll
    for (int e = 0; e < 16; ++e) ss += f[e] * f[e];
    ss += __shfl_xor(ss, 1); ss += __shfl_xor(ss, 2); ss += __shfl_xor(ss, 4);
    const float rn = __builtin_amdgcn_rsqf(ss * (1.0f / 128.0f) + 1e-6f);
    const f32x4 g0 = *(const f32x4*)(gain + sub * 16), g1 = *(const f32x4*)(gain + sub * 16 + 4), g2 = *(const f32x4*)(gain + sub * 16 + 8), g3 = *(const f32x4*)(gain + sub * 16 + 12);
    f[0] *= rn * g0.x; f[1] *= rn * g0.y; f[2] *= rn * g0.z; f[3] *= rn * g0.w; f[4] *= rn * g1.x; f[5] *= rn * g1.y; f[6] *= rn * g1.z; f[7] *= rn * g1.w;
    f[8] *= rn * g2.x; f[9] *= rn * g2.y; f[10] *= rn * g2.z; f[11] *= rn * g2.w; f[12] *= rn * g3.x; f[13] *= rn * g3.y; f[14] *= rn * g3.z; f[15] *= rn * g3.w;
    if (ROPE) {
        const float fp = (float)pos;
#pragma unroll
        for (int e = 0; e < 16; ++e) { const float p = __shfl_xor(f[e], 1);
            if (sub < 2) { const float rv = __builtin_amdgcn_fractf(fp * rope_rf(e)); const float c = __builtin_amdgcn_cosf(rv), s = __builtin_amdgcn_sinf(rv); f[e] = (sub == 0) ? (f[e] * c - p * s) : (f[e] * c + p * s); } }
    }
    v4u o0, o1;
    o0.x = pk2(f[0] * scale, f[1] * scale); o0.y = pk2(f[2] * scale, f[3] * scale); o0.z = pk2(f[4] * scale, f[5] * scale); o0.w = pk2(f[6] * scale, f[7] * scale);
    o1.x = pk2(f[8] * scale, f[9] * scale); o1.y = pk2(f[10] * scale, f[11] * scale); o1.z = pk2(f[12] * scale, f[13] * scale); o1.w = pk2(f[14] * scale, f[15] * scale);
    *(LAS v4u*)(dst + sub * 32) = o0; *(LAS v4u*)(dst + sub * 32 + 16) = o1;
}
template <int OFF> __device__ __forceinline__ void tr_read8(unsigned addr, v2u (&r)[8]) {
    asm volatile("ds_read_b64_tr_b16 %0, %8 offset:%9\n\tds_read_b64_tr_b16 %1, %8 offset:%10\n\tds_read_b64_tr_b16 %2, %8 offset:%11\n\tds_read_b64_tr_b16 %3, %8 offset:%12\n\t"
                 "ds_read_b64_tr_b16 %4, %8 offset:%13\n\tds_read_b64_tr_b16 %5, %8 offset:%14\n\tds_read_b64_tr_b16 %6, %8 offset:%15\n\tds_read_b64_tr_b16 %7, %8 offset:%16\n\ts_waitcnt lgkmcnt(0)"
                 : "=&v"(r[0]), "=&v"(r[1]), "=&v"(r[2]), "=&v"(r[3]), "=&v"(r[4]), "=&v"(r[5]), "=&v"(r[6]), "=&v"(r[7])
                 : "v"(addr), "i"(OFF), "i"(OFF + 4352), "i"(OFF + 32), "i"(OFF + 32 + 4352), "i"(OFF + 64), "i"(OFF + 64 + 4352), "i"(OFF + 96), "i"(OFF + 96 + 4352) : "memory");
}
template <int MODE> __device__ __forceinline__ void attn_super(const Args& a, LAS unsigned char* lds, int sitem, int tid_in, int lane_in, int wave) {
    int tid = tid_in; asm volatile("" : "+v"(tid)); const int lane = tid & 63;
    constexpr int RS = 272, NT = MODE == 0 ? 12 : 16;
    constexpr float SCALE = 0.08838834764831845f;
    LAS unsigned char* Ks = lds; LAS unsigned char* Vs = lds + 256 * RS;
    unsigned char* ws = a.ws;
    const bf16* proj = (const bf16*)(ws + WS_PROJ);
    const int rloc = tid >> 3, sub = tid & 7, l15 = lane & 15, l4 = lane >> 4;
    int b, head, n0 = 0, r = 0, dsh = 0, L = 0, g = 0, slot = 0, qc = 0;
    if (MODE == 0) { b = sitem / 96; const int rem = sitem % 96; head = rem >> 4; const int blk0 = (rem & 15) * 2; g = head >> 1; slot = head & 1; dsh = 2 * g; L = SEQ >> dsh; const int nbsh = 5 - dsh; r = blk0 >> nbsh; n0 = blk0 & ((1 << nbsh) - 1); }
    else { b = sitem >> 6; head = (sitem >> 4) & 3; qc = sitem & 15; }
    const int qloc = 16 * wave + l15; int posq = 0, tokq;
    if (MODE == 0) { posq = ((64 * n0 + qloc) << dsh) + r; tokq = b * SEQ + posq; } else tokq = b * SEQ + 128 * qc + qloc;
    v4u qw[4];
    { const bf16* qrow = proj + (size_t)tokq * NMIX + (MODE == 0 ? head * 128 : 4608 + head * 128);
#pragma unroll
      for (int ks = 0; ks < 4; ++ks) qw[ks] = *(const v4u*)(qrow + 32 * ks + 8 * l4); }
    {
        v4u kw[4][2], vw[4][2]; int spos[4]; const bf16* vsrc[4];
#pragma unroll
        for (int ps = 0; ps < 4; ++ps) { const int kj = ps * 64 + rloc; const v4u z = {0u, 0u, 0u, 0u}; kw[ps][0] = z; kw[ps][1] = z; spos[ps] = 0; vsrc[ps] = nullptr;
            if (MODE == 0) { const int mm = 64 * n0 - 64 + kj; const bool ok = mm >= 0 && mm < L; const int sp = ok ? (mm << dsh) + r : 0; spos[ps] = sp;
                if (ok) { const bf16* rowp = proj + (size_t)(b * SEQ + sp) * NMIX + head * 128 + sub * 16; kw[ps][0] = *(const v4u*)(rowp + 768); kw[ps][1] = *(const v4u*)(rowp + 776); vsrc[ps] = rowp + 1536; } }
            else { const size_t ro = ((size_t)((b * 4 + head) * 256 + kj)) * 128 + sub * 16; const bf16* kp = (const bf16*)(ws + WS_MK) + ro; vsrc[ps] = (const bf16*)(ws + WS_MV) + ro;
                kw[ps][0] = *(const v4u*)kp; kw[ps][1] = *(const v4u*)(kp + 8); } }
#pragma unroll
        for (int ps = 0; ps < 4; ++ps) { const int kj = ps * 64 + rloc;
            if (ps == 2) {
#pragma unroll
                for (int p2 = 0; p2 < 4; ++p2) { const v4u z = {0u, 0u, 0u, 0u}; vw[p2][0] = z; vw[p2][1] = z; if (vsrc[p2]) { vw[p2][0] = *(const v4u*)vsrc[p2]; vw[p2][1] = *(const v4u*)(vsrc[p2] + 8); } } }
            if (MODE == 0) row_norm_store<true>(kw[ps][0], kw[ps][1], a.in[8], spos[ps], 1.0f, Ks + kj * RS, sub);
            else { *(LAS v4u*)(Ks + kj * RS + sub * 32) = kw[ps][0]; *(LAS v4u*)(Ks + kj * RS + sub * 32 + 16) = kw[ps][1]; } }
#pragma unroll
        for (int ps = 0; ps < 4; ++ps) { const int kj = ps * 64 + rloc; *(LAS v4u*)(Vs + kj * RS + sub * 32) = vw[ps][0]; *(LAS v4u*)(Vs + kj * RS + sub * 32 + 16) = vw[ps][1]; }
    }
    bf16x8 qf[4];
    {
        const float* gq = MODE == 0 ? a.in[7] : a.in[22];
        float qv[4][8]; float ss = 0.f;
#pragma unroll
        for (int ks = 0; ks < 4; ++ks) { const v4u w = qw[ks];
            qv[ks][0] = bflo(w.x); qv[ks][1] = bfhi(w.x); qv[ks][2] = bflo(w.y); qv[ks][3] = bfhi(w.y); qv[ks][4] = bflo(w.z); qv[ks][5] = bfhi(w.z); qv[ks][6] = bflo(w.w); qv[ks][7] = bfhi(w.w);
#pragma unroll
            for (int e = 0; e < 8; ++e) ss += qv[ks][e] * qv[ks][e]; }
        ss += __shfl_xor(ss, 16); ss += __shfl_xor(ss, 32);
        const float rn = __builtin_amdgcn_rsqf(ss * (1.0f / 128.0f) + 1e-6f);
#pragma unroll
        for (int ks = 0; ks < 4; ++ks) { const f32x4 g0 = *(const f32x4*)(gq + 32 * ks + 8 * l4), g1 = *(const f32x4*)(gq + 32 * ks + 8 * l4 + 4);
            qv[ks][0] *= rn * g0.x; qv[ks][1] *= rn * g0.y; qv[ks][2] *= rn * g0.z; qv[ks][3] *= rn * g0.w; qv[ks][4] *= rn * g1.x; qv[ks][5] *= rn * g1.y; qv[ks][6] *= rn * g1.z; qv[ks][7] *= rn * g1.w; }
        if (MODE == 0) {
#pragma unroll
            for (int e = 0; e < 8; ++e) { const float p = __shfl_xor(qv[0][e], 32); const float rv = __builtin_amdgcn_fractf((float)posq * ((l4 & 1) ? rope_rf(8 + e) : rope_rf(e))); const float c = __builtin_amdgcn_cosf(rv), sn = __builtin_amdgcn_sinf(rv);
                qv[0][e] = (l4 < 2) ? (qv[0][e] * c - p * sn) : (qv[0][e] * c + p * sn); } }
#pragma unroll
        for (int ks = 0; ks < 4; ++ks) { v4u w; w.x = pk2(qv[ks][0] * SCALE, qv[ks][1] * SCALE); w.y = pk2(qv[ks][2] * SCALE, qv[ks][3] * SCALE); w.z = pk2(qv[ks][4] * SCALE, qv[ks][5] * SCALE); w.w = pk2(qv[ks][6] * SCALE, qv[ks][7] * SCALE);
            qf[ks] = __builtin_bit_cast(bf16x8, w); }
    }
    __syncthreads();
    const int kt0 = MODE == 0 ? 4 * (wave >> 2) : 0;
    f32x4 st[NT]; float mx = -3e38f;
#pragma unroll
    for (int t = 0; t < NT; ++t) { const int kt = kt0 + t; f32x4 acc = {0.f, 0.f, 0.f, 0.f};
#pragma unroll
        for (int ks = 0; ks < 4; ++ks) { const bf16x8 kf = *(const LAS bf16x8*)(Ks + (16 * kt + l15) * RS + (32 * ks + 8 * l4) * 2); acc = __builtin_amdgcn_mfma_f32_16x16x32_bf16(kf, qf[ks], acc, 0, 0, 0); }
        if (MODE == 0) {
#pragma unroll
            for (int v = 0; v < 4; ++v) { const int kj = 16 * kt + 4 * l4 + v, rel = kj - 64 - qloc, mm = 64 * n0 - 64 + kj; const bool ok = rel >= -64 && rel <= 64 && mm >= 0 && mm < L; acc[v] = ok ? acc[v] : -1e30f; } }
        st[t] = acc; mx = fmaxf(fmaxf(mx, fmaxf(acc[0], acc[1])), fmaxf(acc[2], acc[3])); }
    mx = fmaxf(mx, __shfl_xor(mx, 16)); mx = fmaxf(mx, __shfl_xor(mx, 32));
    float sum = 0.f;
#pragma unroll
    for (int t = 0; t < NT; ++t)
#pragma unroll
        for (int v = 0; v < 4; ++v) { st[t][v] = fexp(st[t][v] - mx); sum += st[t][v]; }
    sum += __shfl_xor(sum, 16); sum += __shfl_xor(sum, 32);
    const float inv = 1.0f / sum;
    if (MODE == 0 && l4 == 0) ((float*)(ws + WS_LSE))[((size_t)g * T + tokq) * 2 + slot] = mx + __logf(sum);
    v2u pkp[NT];
#pragma unroll
    for (int t = 0; t < NT; ++t) { pkp[t].x = pk2(st[t][0] * inv, st[t][1] * inv); pkp[t].y = pk2(st[t][2] * inv, st[t][3] * inv); }
    asm volatile("" ::: "memory");
    f32x4 oacc[8];
#pragma unroll
    for (int dt = 0; dt < 8; ++dt) oacc[dt] = (f32x4){0.f, 0.f, 0.f, 0.f};
    const unsigned vbase = (unsigned)(size_t)Vs + (unsigned)((16 * kt0 + 4 * l4 + (l15 >> 2)) * RS + (l15 & 3) * 8);
#pragma unroll
    for (int sl = 0; sl < NT / 2; ++sl) {
        v4u pw; pw.x = pkp[2 * sl].x; pw.y = pkp[2 * sl].y; pw.z = pkp[2 * sl + 1].x; pw.w = pkp[2 * sl + 1].y;
        const bf16x8 pf = __builtin_bit_cast(bf16x8, pw);
        const unsigned va = vbase + (unsigned)(sl * 32 * RS);
        v2u rr[8];
        tr_read8<0>(va, rr);
#pragma unroll
        for (int k = 0; k < 4; ++k) { v4u wv; wv.x = rr[2 * k].x; wv.y = rr[2 * k].y; wv.z = rr[2 * k + 1].x; wv.w = rr[2 * k + 1].y; oacc[k] = __builtin_amdgcn_mfma_f32_16x16x32_bf16(__builtin_bit_cast(bf16x8, wv), pf, oacc[k], 0, 0, 0); }
        tr_read8<128>(va, rr);
#pragma unroll
        for (int k = 0; k < 4; ++k) { v4u wv; wv.x = rr[2 * k].x; wv.y = rr[2 * k].y; wv.z = rr[2 * k + 1].x; wv.w = rr[2 * k + 1].y; oacc[4 + k] = __builtin_amdgcn_mfma_f32_16x16x32_bf16(__builtin_bit_cast(bf16x8, wv), pf, oacc[4 + k], 0, 0, 0); }
    }
    bf16* orow = MODE == 0 ? (bf16*)((unsigned char*)a.out + OUT_OG) + ((size_t)g * T + tokq) * 256 + slot * 128 : (bf16*)(ws + WS_YCAT) + (size_t)tokq * YCP + 1024 + head * 128;
#pragma unroll
    for (int dt = 0; dt < 8; ++dt) { v2u o; o.x = pk2(oacc[dt][0], oacc[dt][1]); o.y = pk2(oacc[dt][2], oacc[dt][3]); *(v2u*)(orow + 16 * dt + 4 * l4) = o; }
    __syncthreads();
}
__device__ __forceinline__ void hy_load_tile(const bf16* proj, int b, int t0, int col0, int lane, v4u (&w)[5]) {
    const int rr = lane >> 2, c4 = lane & 3;
#pragma unroll
    for (int it = 0; it < 5; ++it) { const int row = it * 16 + rr, tt = t0 - 1 + row; const v4u z = {0u, 0u, 0u, 0u}; w[it] = z;
        if (row < 66 && tt >= 0 && tt < SEQ) w[it] = *(const v4u*)(proj + (size_t)(b * SEQ + tt) * NMIX + col0 + 8 * c4); }
}
__device__ __forceinline__ void hy_put_tile(const v4u (&w)[5], LAS float* tl, int lane) {
    const int rr = lane >> 2, c4 = lane & 3;
#pragma unroll
    for (int it = 0; it < 5; ++it) { const int row = it * 16 + rr;
        if (row < 66) { LAS float* d = tl + row * 33 + 8 * c4; d[0] = bflo(w[it].x); d[1] = bfhi(w[it].x); d[2] = bflo(w[it].y); d[3] = bfhi(w[it].y); d[4] = bflo(w[it].z); d[5] = bfhi(w[it].z); d[6] = bflo(w[it].w); d[7] = bfhi(w[it].w); } }
}
__device__ __forceinline__ void hy_stage_tile(const bf16* proj, int b, int t0, int col0, LAS float* tl, int lane) { v4u w[5]; hy_load_tile(proj, b, t0, col0, lane, w); hy_put_tile(w, tl, lane); }
__device__ __forceinline__ void hy_conv8(const LAS float* tl, int j, int q, const float* __restrict__ cw, const float* __restrict__ cbv, int ch, float (&o)[8]) {
    const float w0 = cw[ch], w1 = cw[2304 + ch], w2 = cw[4608 + ch], bs = cbv[ch]; float Lr[10];
#pragma unroll
    for (int k = 0; k < 10; ++k) Lr[k] = tl[(8 * q + k) * 33 + j];
#pragma unroll
    for (int e = 0; e < 8; ++e) o[e] = w0 * Lr[e] + w1 * Lr[e + 1] + w2 * Lr[e + 2] + bs;
}
__device__ __forceinline__ void hyprep_decode(int item, int& p, int& b, int& t0, int& c0) { c0 = (item % 24) * 32; t0 = ((item / 24) & 31) * 64; b = (item / 768) & 7; p = item / 6144; }
__device__ __forceinline__ void hyprep_all(const Args& a, LAS float* tl, int gw, int NGW, int lane) {
    constexpr int NIT = 12288;
    const bf16* proj = (const bf16*)(a.ws + WS_PROJ); bf16* hv = (bf16*)(a.ws + WS_HV);
    int item = gw, p, b, t0, c0; v4u w[5], wn[5];
    if (item < NIT) { hyprep_decode(item, p, b, t0, c0); hy_load_tile(proj, b, t0, 2304 + p * 768 + c0, lane, w); }
    while (item < NIT) { const int nit = item + NGW;
        if (nit < NIT) { int p2, b2, t2, c2; hyprep_decode(nit, p2, b2, t2, c2); hy_load_tile(proj, b2, t2, 2304 + p2 * 768 + c2, lane, wn); }
        hyprep_decode(item, p, b, t0, c0);
        hy_put_tile(w, tl, lane);
        LDS_WAIT(); asm volatile("" ::: "memory");
#pragma unroll
        for (int it = 0; it < 4; ++it) { const int j = it * 8 + (lane >> 3), q = lane & 7; float o[8]; hy_conv8(tl, j, q, a.in[9], a.in[10], p * 768 + c0 + j, o);
            v4u wo; wo.x = pk2(o[0], o[1]); wo.y = pk2(o[2], o[3]); wo.z = pk2(o[4], o[5]); wo.w = pk2(o[6], o[7]);
            *(v4u*)(hv + (((size_t)p * 768 + c0 + j) * 8 + b) * SEQ + t0 + 8 * q) = wo; }
        LDS_WAIT(); asm volatile("" ::: "memory");
#pragma unroll
        for (int i = 0; i < 5; ++i) w[i] = wn[i];
        item = nit; }
}
constexpr int HY_US = 2336, HY_PADL = 256, HY_CL = 4352, HY_CSB = HY_CL * 2 + 32;
constexpr int HY_FCP = 8192, HY_UT = HY_FCP + 8 * HY_CSB, HY_LDS_END = HY_UT + 8 * HY_US * 2;
__device__ __forceinline__ void hyconv_phase(const Args& a, LAS unsigned char* lds, int bid, int G, int tid_in, int wave) {
    int tid = tid_in; asm volatile("" : "+v"(tid)); const int lane = tid & 63;
    unsigned char* ws = a.ws;
    LAS unsigned short* fbase = (LAS unsigned short*)lds;
    LAS unsigned char* fcp = lds + HY_FCP;
    LAS unsigned short* uT = (LAS unsigned short*)(lds + HY_UT);
    const bf16* kc = (const bf16*)(ws + WS_KC); const bf16* hv = (const bf16*)(ws + WS_HV); const float* cen = (const float*)(ws + WS_CEN); const float* hbias = a.in[19];
    const int i15 = lane & 15, kq = lane >> 4, bb = lane & 7, ah = (lane >> 3) & 1;
    const LAS unsigned char* cp = fcp + (i15 & 7) * HY_CSB + (2304 + 8 * kq - 8 * (i15 >> 3)) * 2;
    const LAS unsigned short* ub = uT + bb * HY_US + HY_PADL + 16 * ah + 8 * kq;
    for (int i = tid; i < 8 * HY_US / 2; i += NTHR) ((LAS unsigned*)(lds + HY_UT))[i] = 0u;
    int c = bid; v4u fpre = {0u, 0u, 0u, 0u}, upre[4]; float cpre = 0.f;
#pragma unroll
    for (int i = 0; i < 4; ++i) upre[i] = fpre;
    if (c < HYW) {
        fpre = *(const v4u*)(kc + ((size_t)c) * 4096 + tid * 8); cpre = cen[c] + cen[768 + c] + hbias[c];
#pragma unroll
        for (int i = 0; i < 4; ++i) { const int idx = tid + 512 * i; upre[i] = *(const v4u*)(hv + ((size_t)c * 8 + (idx >> 8)) * SEQ + (idx & 255) * 8); } }
    while (c < HYW) {
        __syncthreads();
#pragma unroll
        for (int i = 0; i < 4; ++i) { const int idx = tid + 512 * i; *(LAS v4u*)(uT + (idx >> 8) * HY_US + HY_PADL + (idx & 255) * 8) = upre[i]; }
#pragma unroll
        for (int o = 0; o < 2; ++o) {
            if (o == 1) __syncthreads();
            *(LAS v4u*)(fbase + tid * 8) = fpre;
            const unsigned cbits = f2bf(cpre);
            __syncthreads();
#pragma unroll
            for (int r = 0; r < 8; ++r)
#pragma unroll
                for (int k = 0; k < 5; ++k) { const int y2 = tid + 512 * k;
                    if (y2 < HY_CL / 2) { const int d0 = r - 2 * y2 + 2304, d1 = d0 - 1;
                        unsigned v0 = (d0 > -2048 && d0 < 2048) ? (unsigned)fbase[d0 + 2048] : 0u, v1 = (d1 > -2048 && d1 < 2048) ? (unsigned)fbase[d1 + 2048] : 0u;
                        v0 = d0 == 0 ? cbits : v0; v1 = d1 == 0 ? cbits : v1;
                        *(LAS unsigned*)(fcp + r * HY_CSB + y2 * 4) = v0 | (v1 << 16); } }
            __syncthreads();
            v2u x1r[8];
            if (o == 0) {
                fpre = *(const v4u*)(kc + ((size_t)(768 + c)) * 4096 + tid * 8); cpre = cen[2 * 768 + c] + cen[3 * 768 + c] + hbias[768 + c];
#pragma unroll
                for (int n = 0; n < 8; ++n) x1r[n] = *(const v2u*)(hv + (((size_t)768 + c) * 8 + bb) * SEQ + 256 * wave + 32 * n + 16 * ah + 4 * kq);
            } else { const int cn = c + G;
                if (cn < HYW) { fpre = *(const v4u*)(kc + ((size_t)cn) * 4096 + tid * 8); cpre = cen[cn] + cen[768 + cn] + hbias[cn];
#pragma unroll
                    for (int i = 0; i < 4; ++i) { const int idx = tid + 512 * i; upre[i] = *(const v4u*)(hv + ((size_t)cn * 8 + (idx >> 8)) * SEQ + (idx & 255) * 8); } } }
            f32x4 acc[8];
#pragma unroll
            for (int n = 0; n < 8; ++n) acc[n] = (f32x4){0.f, 0.f, 0.f, 0.f};
            bf16x8 AF[8];
#pragma unroll
            for (int sl = 2; sl < 8; ++sl) AF[sl] = *(const LAS bf16x8*)(cp - 64 * (8 * wave + sl));
            AF[0] = *(const LAS bf16x8*)(cp - 64 * (8 * wave + 8));
            { AF[1] = *(const LAS bf16x8*)(cp - 64 * (8 * wave + 1));
              const bf16x8 bf = *(const LAS bf16x8*)(ub - 32);
#pragma unroll
              for (int n = 0; n < 8; ++n) acc[n] = __builtin_amdgcn_mfma_f32_16x16x32_bf16(AF[(n + 1) & 7], bf, acc[n], 0, 0, 0); }
#pragma unroll 1
            for (int m = 1; m < 9; ++m) {
#pragma unroll
                for (int u = 0; u < 8; ++u) { const int sig = 8 * m + u - 8;
                    AF[(8 - u) & 7] = *(const LAS bf16x8*)(cp - 64 * (8 * wave - sig));
                    const bf16x8 bf = *(const LAS bf16x8*)(ub + 32 * sig);
#pragma unroll
                    for (int n = 0; n < 8; ++n) acc[n] = __builtin_amdgcn_mfma_f32_16x16x32_bf16(AF[(n - u) & 7], bf, acc[n], 0, 0, 0); }
            }
            if (o == 0) {
                __syncthreads();
#pragma unroll
                for (int n = 0; n < 8; ++n) { const int t = 256 * wave + 32 * n + 16 * ah + 4 * kq; const v2u x1 = x1r[n];
                    v2u y; y.x = pk2(acc[n][0] * bflo(x1.x), acc[n][1] * bfhi(x1.x)); y.y = pk2(acc[n][2] * bflo(x1.y), acc[n][3] * bfhi(x1.y)); *(LAS v2u*)(uT + bb * HY_US + HY_PADL + t) = y; }
            } else {
#pragma unroll
                for (int n = 0; n < 8; ++n) { const int t = 256 * wave + 32 * n + 16 * ah + 4 * kq; v2u y; y.x = pk2(acc[n][0], acc[n][1]); y.y = pk2(acc[n][2], acc[n][3]); *(v2u*)((bf16*)((unsigned char*)a.out + OUT_HZ) + ((size_t)c * 8 + bb) * SEQ + t) = y; }
            }
        }
        c += G;
    }
    __syncthreads();
}
__device__ __forceinline__ void hyout_load(const bf16* proj, const bf16* hz, int item, int lane, v4u (&hw)[4], v4u (&w)[5]) {
    const int c0 = (item % 24) * 32, t0 = ((item / 24) & 31) * 64, b = item / 768;
#pragma unroll
    for (int it = 0; it < 4; ++it) { const int j = it * 8 + (lane >> 3), q = lane & 7; hw[it] = *(const v4u*)(hz + ((size_t)(c0 + j) * 8 + b) * SEQ + t0 + 8 * q); }
    hy_load_tile(proj, b, t0, 2304 + 1536 + c0, lane, w);
}
__device__ __forceinline__ void hyout_all(const Args& a, LAS float* tl, int gw, int NGW, int lane) {
    constexpr int NIT = 6144;
    const bf16* proj = (const bf16*)(a.ws + WS_PROJ); const bf16* hz = (const bf16*)((const unsigned char*)a.out + OUT_HZ); bf16* yb = (bf16*)(a.ws + WS_YCAT) + 256;
    LAS float* tl2 = tl + 66 * 33;
    int item = gw; v4u hw[4], w[5], hwn[4], wn[5];
    if (item < NIT) hyout_load(proj, hz, item, lane, hw, w);
    while (item < NIT) { const int nit = item + NGW;
        if (nit < NIT) hyout_load(proj, hz, nit, lane, hwn, wn);
        const int c0 = (item % 24) * 32, t0 = ((item / 24) & 31) * 64, b = item / 768;
        hy_put_tile(w, tl, lane);
        LDS_WAIT(); asm volatile("" ::: "memory");
#pragma unroll
        for (int it = 0; it < 4; ++it) { const int j = it * 8 + (lane >> 3), q = lane & 7; float o[8]; hy_conv8(tl, j, q, a.in[9], a.in[10], 1536 + c0 + j, o);
            LAS float* d = tl2 + (8 * q) * 33 + j;
            d[0] = o[0] * bflo(hw[it].x); d[33] = o[1] * bfhi(hw[it].x); d[2 * 33] = o[2] * bflo(hw[it].y); d[3 * 33] = o[3] * bfhi(hw[it].y);
            d[4 * 33] = o[4] * bflo(hw[it].z); d[5 * 33] = o[5] * bfhi(hw[it].z); d[6 * 33] = o[6] * bflo(hw[it].w); d[7 * 33] = o[7] * bfhi(hw[it].w); }
        LDS_WAIT(); asm volatile("" ::: "memory");
#pragma unroll 4
        for (int it = 0; it < 16; ++it) { const int t = 4 * it + (lane >> 4), j2 = (lane & 15) * 2; const LAS float* sp = tl2 + t * 33 + j2;
            *(unsigned*)(yb + (size_t)(b * SEQ + t0 + t) * YCP + c0 + j2) = pk2(sp[0], sp[1]); }
        LDS_WAIT(); asm volatile("" ::: "memory");
#pragma unroll
        for (int i = 0; i < 4; ++i) hw[i] = hwn[i];
#pragma unroll
        for (int i = 0; i < 5; ++i) w[i] = wn[i];
        item = nit; }
}

constexpr int LDS_RTAB = 131072;
__device__ __forceinline__ const LAS float* fill_rtab(LAS unsigned char* lds, const float* ssrow, const pg8::StaticOrder& S, int tid) {
    LAS float* rt = (LAS float*)(lds + LDS_RTAB); pg8::Unit u;
    for (int i = 0; S.next(i, u); ++i) if (tid < 256) rt[i * 256 + tid] = __builtin_amdgcn_rsqf(ssrow[u.pm * 256 + tid] * (1.0f / 2048.0f) + 1e-6f);
    __syncthreads();
    return rt;
}
__global__ void __launch_bounds__(NTHR, 2) mk_fwd(Args a) {
    extern __shared__ __attribute__((aligned(16))) unsigned char lds_raw[];
    LAS unsigned char* lds = (LAS unsigned char*)lds_raw;
    const int tid = threadIdx.x, lane = tid & 63, wave = __builtin_amdgcn_readfirstlane(tid >> 6), bid = blockIdx.x, G = gridDim.x;
    const int gw = bid * NWAVES + wave, NGW = G * NWAVES;
    unsigned char* ws = a.ws;
    const int lo = a.ph_lo, hi = a.ph_hi;
    float* ss = (float*)(ws + WS_SS);
    bf16* xb = (bf16*)(ws + WS_XB);
#ifndef PH_MASK
#define PH_MASK 0xFFF
#endif
#define IN(k) ((((PH_MASK) >> (k)) & 1) && lo <= (k) && (k) < hi)
#ifndef DUP_MASK
#define DUP_MASK 0
#endif
#define REP(k) _Pragma("unroll") for (int rep_ = 0; rep_ < 1 + (((DUP_MASK) >> (k)) & 1); ++rep_)
    { volatile LAS unsigned* misc0 = (volatile LAS unsigned*)(lds + LDS_MISC); if (tid < 2) misc0[tid] = 0u; }
    __syncthreads();
    (void)xcd_barrier_post((unsigned*)(ws + WS_BAR), (volatile LAS unsigned*)(lds + LDS_MISC));
#define GRID_BAR() do { XcdBarrier b_; b_.bar = (unsigned*)(a.ws + WS_BAR); b_.x = xb_xcc_id(); b_.st = (volatile LAS unsigned*)(lds + LDS_MISC); xcd_barrier(b_); } while (0)
#define SEAM(k) do { if (IN(k) && IN((k) + 1)) { if (a.ph_lo < 0) cg::this_grid().sync();   else { XcdBarrier b_; b_.bar = (unsigned*)(a.ws + WS_BAR); b_.x = xb_xcc_id(); b_.st = (volatile LAS unsigned*)(lds + LDS_MISC); xcd_barrier(b_); } } } while (0)
    if (IN(0)) { phase0(a, lds, tid, lane, wave, bid, G); __syncthreads(); }
    SEAM(0);
    if (IN(1)) REP(1) {
        { LAS float* hb = (LAS float*)(lds + wave * 18432); for (int it = gw; it < 1536; it += NGW) hy_l4_item(a, hb, it, lane); __syncthreads(); }
        for (int tile = bid; tile < 256; tile += G) memkv_tile(a, lds, tile, tid, lane, wave);
        pg8::Gemm g{xb, (const bf16*)(ws + WS_WFFIN), T, NIN, DM, XP, XP}; pg8::StaticOrder S; S.init(T, NIN, G, bid);
        pg8::EpiSwiGLU E{(bf16*)(ws + WS_ACT), FF, fill_rtab(lds, ss, S, tid)};
        pg8::gemm_phase<pg8::EpiSwiGLU, pg8::StaticOrder, GEMM_ALIGN, GEMM_SP2>(lds, g, S, E);
    }
    SEAM(1);
    if (IN(2)) {
        pg8::Gemm g{(const bf16*)(ws + WS_ACT), (const bf16*)(ws + WS_WFFOUT), T, DM, FF, FF, FF}; pg8::StaticOrder S; S.init(T, DM, G, bid);
        pg8::EpiResid E{xb, ss + T, 0.5f, XP};
        pg8::gemm_phase<pg8::EpiResid, pg8::StaticOrder, RESID_ALIGN, GEMM_SP2>(lds, g, S, E);
    }
    SEAM(2);
    if (IN(3)) REP(3) {
        pg8::Gemm g{xb, (const bf16*)(ws + WS_WIN), T, NMIX, DM, XP, XP}; pg8::StaticOrder S; S.init(T, NMIX, G, bid);
        pg8::EpiScale<0> E{(bf16*)(ws + WS_PROJ), NMIX, fill_rtab(lds, ss + T, S, tid)};
        pg8::gemm_phase<pg8::EpiScale<0>, pg8::StaticOrder, GEMM_ALIGN, GEMM_SP2>(lds, g, S, E);
    }
    SEAM(3);
    if (IN(4)) REP(4) {
#ifndef P4_ATTN_REPS
#define P4_ATTN_REPS 1
#endif
#ifndef P4_WAVE_REPS
#define P4_WAVE_REPS 1
#endif
#pragma unroll 1
        for (int rp = 0; rp < P4_ATTN_REPS; ++rp) {
        for (int it = bid; it < 768; it += G) attn_super<0>(a, lds, it, tid, lane, wave);
        for (int it = bid; it < 512; it += G) attn_super<1>(a, lds, it, tid, lane, wave);
        }
        LAS float* scr = (LAS float*)(lds + wave * 16384);
#pragma unroll 1
        for (int rp = 0; rp < P4_WAVE_REPS; ++rp) {
        hyprep_all(a, scr, gw, NGW, lane);
        cvt_matrix(a.in[29], DM, NIN, a.in[28], (bf16*)(ws + WS_WFFIN), XP, 1, scr, gw, NGW, lane);
        cvt_matrix(a.in[30], FF, DM, nullptr, (bf16*)(ws + WS_WFFOUT), FF, 0, scr, gw, NGW, lane);
        }
        __syncthreads();
    }
    SEAM(4);
    if (IN(5)) REP(5) {
        hyconv_phase(a, lds, bid, G, tid, wave);
        const float* lse = (const float*)(ws + WS_LSE); const bf16* og = (const bf16*)((const unsigned char*)a.out + OUT_OG); bf16* ya = (bf16*)(ws + WS_YCAT);
        for (int idx = bid * NTHR + tid; idx < T * 32; idx += G * NTHR) { const int token = idx >> 5, c8 = idx & 31, slot = c8 >> 4;
            const float l0 = lse[(size_t)token * 2 + slot], l1 = lse[((size_t)T + token) * 2 + slot], l2 = lse[((size_t)2 * T + token) * 2 + slot];
            const float mx = fmaxf(l0, fmaxf(l1, l2)); float w0 = fexp(l0 - mx), w1 = fexp(l1 - mx), w2 = fexp(l2 - mx); const float inv = 1.0f / (w0 + w1 + w2); w0 *= inv; w1 *= inv; w2 *= inv;
            const v4u o0 = *(const v4u*)(og + (size_t)token * 256 + c8 * 8), o1 = *(const v4u*)(og + ((size_t)T + token) * 256 + c8 * 8), o2 = *(const v4u*)(og + ((size_t)2 * T + token) * 256 + c8 * 8);
            v4u y;
            y.x = pk2(w0 * bflo(o0.x) + w1 * bflo(o1.x) + w2 * bflo(o2.x), w0 * bfhi(o0.x) + w1 * bfhi(o1.x) + w2 * bfhi(o2.x));
            y.y = pk2(w0 * bflo(o0.y) + w1 * bflo(o1.y) + w2 * bflo(o2.y), w0 * bfhi(o0.y) + w1 * bfhi(o1.y) + w2 * bfhi(o2.y));
            y.z = pk2(w0 * bflo(o0.z) + w1 * bflo(o1.z) + w2 * bflo(o2.z), w0 * bfhi(o0.z) + w1 * bfhi(o1.z) + w2 * bfhi(o2.z));
            y.w = pk2(w0 * bflo(o0.w) + w1 * bflo(o1.w) + w2 * bflo(o2.w), w0 * bfhi(o0.w) + w1 * bfhi(o1.w) + w2 * bfhi(o2.w));
            *(v4u*)(ya + (size_t)token * YCP + c8 * 8) = y; }
    }
    SEAM(5);
    if (IN(6)) REP(6) {
        LAS float* scr = (LAS float*)(lds + wave * 18432);
        hyout_all(a, scr, gw, NGW, lane);
        __syncthreads();
    }
    SEAM(6);
    if (IN(7)) REP(7) {
        { pg8::Gemm g{xb, (const bf16*)(ws + WS_WIN) + (size_t)NMIX * XP, T, 3 * DM, DM, XP, XP}; pg8::StaticOrder S; S.init(T, 3 * DM, G, bid);
          pg8::EpiGate8 E{ws + WS_G, 3 * DM, fill_rtab(lds, ss + T, S, tid)};
          pg8::gemm_phase<pg8::EpiGate8, pg8::StaticOrder, GEMM_ALIGN, GEMM_SP2>(lds, g, S, E); }
        GRID_BAR();
        { pg8::Gemm g{(const bf16*)(ws + WS_YCAT), (const bf16*)(ws + WS_WBR), T, DM, YCP, YCP, YCP}; pg8::StaticOrder S; S.init(T, DM, G, bid);
          pg8::EpiMergeCat E{ws + WS_G, (bf16*)(ws + WS_MG), 3 * DM, XP};
          pg8::gemm_phase<pg8::EpiMergeCat, pg8::StaticOrder, GEMM_ALIGN, GEMM_SP2>(lds, g, S, E); }
    }
    SEAM(7);
    if (IN(8)) {
        pg8::Gemm g{(const bf16*)(ws + WS_MG), (const bf16*)(ws + WS_WOUT), T, DM, DM, XP, XP}; pg8::StaticOrder S; S.init(T, DM, G, bid);
        pg8::EpiResid E{xb, ss + 2 * T, 1.0f, XP};
        pg8::gemm_phase<pg8::EpiResid, pg8::StaticOrder, RESID_ALIGN, GEMM_SP2>(lds, g, S, E);
    }
    SEAM(8);
    if (IN(9)) {
        pg8::Gemm g{xb, (const bf16*)(ws + WS_WFFIN), T, NIN, DM, XP, XP}; pg8::StaticOrder S; S.init(T, NIN, G, bid);
        pg8::EpiSwiGLU E{(bf16*)(ws + WS_ACT), FF, fill_rtab(lds, ss + 2 * T, S, tid)};
        pg8::gemm_phase<pg8::EpiSwiGLU, pg8::StaticOrder, GEMM_ALIGN, GEMM_SP2>(lds, g, S, E);
    }
    SEAM(9);
    if (IN(10)) {
        pg8::Gemm g{(const bf16*)(ws + WS_ACT), (const bf16*)(ws + WS_WFFOUT), T, DM, FF, FF, FF}; pg8::StaticOrder S; S.init(T, DM, G, bid);
        pg8::EpiResid E{xb, ss + 3 * T, 0.5f, XP};
        pg8::gemm_phase<pg8::EpiResid, pg8::StaticOrder, RESID_ALIGN, GEMM_SP2>(lds, g, S, E);
    }
    SEAM(10);
    if (IN(11)) {
        const float* gp = a.in[31];
        f32x4 gg[4][2];
#pragma unroll
        for (int j = 0; j < 4; ++j) { const int c8 = (lane + 64 * j) * 8; gg[j][0] = *(const f32x4*)(gp + c8); gg[j][1] = *(const f32x4*)(gp + c8 + 4); }
        int row = gw; v4u w[4], wn[4]; float ssr = 0.f, ssn = 0.f;
        if (row < T) { ssr = ss[3 * T + row];
#pragma unroll
            for (int j = 0; j < 4; ++j) w[j] = ((const v4u*)(xb + (size_t)row * XP))[lane + 64 * j]; }
        while (row < T) { const int nrow = row + NGW;
            if (nrow < T) { ssn = ss[3 * T + nrow];
#pragma unroll
                for (int j = 0; j < 4; ++j) wn[j] = ((const v4u*)(xb + (size_t)nrow * XP))[lane + 64 * j]; }
            f32x4* orow = (f32x4*)(a.out + (size_t)row * DM); const float r = __builtin_amdgcn_rsqf(ssr * (1.0f / 2048.0f) + 1e-6f);
#pragma unroll
            for (int j = 0; j < 4; ++j) { const f32x4 g0 = gg[j][0], g1 = gg[j][1];
                orow[(lane + 64 * j) * 2] = (f32x4){bflo(w[j].x) * r * g0.x, bfhi(w[j].x) * r * g0.y, bflo(w[j].y) * r * g0.z, bfhi(w[j].y) * r * g0.w};
                orow[(lane + 64 * j) * 2 + 1] = (f32x4){bflo(w[j].z) * r * g1.x, bfhi(w[j].z) * r * g1.y, bflo(w[j].w) * r * g1.z, bfhi(w[j].w) * r * g1.w}; }
#pragma unroll
            for (int j = 0; j < 4; ++j) w[j] = wn[j];
            ssr = ssn; row = nrow; }
    }
#ifdef EXTRA_SYNCS
    for (int i = 0; i < EXTRA_SYNCS; ++i) GRID_BAR();
#endif
#undef IN
#undef SEAM
}

extern "C" void kernel_launch(void* const* d_in, const int* in_sizes, int n_in, void* d_out, int out_size, void* d_ws, size_t ws_size, hipStream_t stream) {
    static int grid = 0;
    if (grid == 0) {
        if (n_in != 32 || in_sizes[0] != T * DM || out_size != T * DM || ws_size < WS_END) { fprintf(stderr, "kernel_launch: unexpected problem (n_in %d, in0 %d, out %d, ws %zu < %zu); nothing launched\n", n_in, n_in > 0 ? in_sizes[0] : -1, out_size, ws_size, (size_t)WS_END); grid = -1; return; }
        int dev = 0, cus = 0, per_cu = 0;
        if (hipGetDevice(&dev) != hipSuccess || hipDeviceGetAttribute(&cus, hipDeviceAttributeMultiprocessorCount, dev) != hipSuccess) { fprintf(stderr, "kernel_launch: device query failed\n"); grid = -1; return; }
        if (hipFuncSetAttribute((const void*)mk_fwd, hipFuncAttributeMaxDynamicSharedMemorySize, LDS_BYTES) != hipSuccess) { fprintf(stderr, "kernel_launch: hipFuncSetAttribute failed\n"); grid = -1; return; }
        if (hipOccupancyMaxActiveBlocksPerMultiprocessor(&per_cu, (const void*)mk_fwd, NTHR, LDS_BYTES) != hipSuccess || per_cu < 1) { fprintf(stderr, "kernel_launch: occupancy query says %d\n", per_cu); per_cu = 1; }
        (void)hipGetLastError();
        grid = cus;
    }
    if (grid < 0) return;
    Args a{};
    for (int i = 0; i < 32; ++i) a.in[i] = (const float*)d_in[i];
    a.out = (float*)d_out; a.ws = (unsigned char*)d_ws;
#if MK_N_LAUNCHES == 1
    if (hipMemsetAsync((unsigned char*)d_ws + WS_BAR, 0, XCD_BAR_WORDS * 4, stream) != hipSuccess) { fprintf(stderr, "kernel_launch: memset of the barrier words failed\n"); return; }
    a.ph_lo = 0; a.ph_hi = NPHASE;
    void* args[] = {&a};
    hipError_t e = hipLaunchCooperativeKernel((const void*)mk_fwd, dim3(grid), dim3(NTHR), args, LDS_BYTES, stream);
    if (e != hipSuccess) fprintf(stderr, "kernel_launch: cooperative launch failed: %s (grid %d)\n", hipGetErrorString(e), grid);
#else
    for (int p = 0; p < NPHASE; ++p) { a.ph_lo = p; a.ph_hi = p + 1; hipLaunchKernelGGL(mk_fwd, dim3(grid), dim3(NTHR), LDS_BYTES, stream, a); }
#endif
}
```

```cpp
#include <hip/hip_runtime.h>
#include <hip/hip_cooperative_groups.h>
#include <cstdio>
#include <cstdint>
namespace cg = cooperative_groups;
#ifndef MK_N_LAUNCHES
#define MK_N_LAUNCHES 1
#endif
#ifndef GEMM_ALIGN
#define GEMM_ALIGN true
#endif
#ifndef GEMM_SP2
#define GEMM_SP2 true
#endif
#ifndef RESID_ALIGN
#define RESID_ALIGN true
#endif
#define DUP_MASK 0x00

namespace pg8 {
#define PG8_LAS __attribute__((address_space(3)))
typedef unsigned short bf16_t;
typedef short bf16x8 __attribute__((ext_vector_type(8)));
typedef float f32x4 __attribute__((ext_vector_type(4)));
typedef unsigned u32x4 __attribute__((ext_vector_type(4)));
constexpr int BM = 256, BK = 64, HALF = 128, HTB = HALF * BK * 2  , STAGE_BYTES = 8 * HTB, NXCD = 8, WGM = 8;

__host__ __device__ __forceinline__ int lds_byte(int r, int c) { const int st = (r >> 4) * 2 + (c >> 5), rr = r & 15, cc = c & 31, ob = rr * 64 + cc * 2; return st * 1024 + (ob ^ (((ob >> 9) & 1) << 5)); }
__host__ __device__ __forceinline__ void stage_rc(int b, int& R, int& C) { const int st = b / 1024, sb = b % 1024, swz = sb ^ (((sb >> 9) & 1) << 5); R = (st >> 1) * 16 + swz / 64; C = (st & 1) * 32 + (swz % 64) / 2; }
__host__ __device__ __forceinline__ int perm32(int rho) { const int n = rho >> 4, i = rho & 15; return 8 * (i >> 2) + 4 * n + (i & 3); }

struct Unit { int pm, pn, ui; };
struct Gemm { const bf16_t* A; const bf16_t* Bt; int M, N, K, lda, ldb; };

struct StaticOrder {
    int nM, nN, nwg, G, c;
    __host__ __device__ void init(int M, int N, int G_, int c_) { nM = M / BM; nN = N / BM; nwg = nM * nN; G = G_; c = c_; }
    __host__ __device__ bool next(int i, Unit& u) const {
        const long L = (long)i * G + c; if (L >= nwg) return false;
        int wgid = (int)L; { const int q = nwg / NXCD, r = nwg % NXCD, xcd = wgid % NXCD, off = wgid / NXCD; wgid = (xcd < r ? xcd * (q + 1) : r * (q + 1) + (xcd - r) * q) + off; }
        const int nig = WGM * nN, gid = wgid / nig, fm = gid * WGM, gsz = (nM - fm) < WGM ? (nM - fm) : WGM;
        u.pm = fm + ((wgid % nig) % gsz); u.pn = (wgid % nig) / gsz; u.ui = i; return true;
    }
    __device__ __forceinline__ void a_ready(const Unit&) const {}
    __device__ __forceinline__ void done(const Unit&) const {}
};
__device__ __forceinline__ unsigned cvt_pk_bf16(float lo, float hi) { unsigned r; asm volatile("v_cvt_pk_bf16_f32 %0, %1, %2" : "=v"(r) : "v"(lo), "v"(hi)); return r; }
typedef float f32x2 __attribute__((ext_vector_type(2)));
typedef unsigned u32x2 __attribute__((ext_vector_type(2)));
__device__ __forceinline__ float rinv_of(const PG8_LAS float* rtab, const Unit& u, int rt) { return rtab[u.ui * BM + rt]; }
__device__ __forceinline__ float sigm(float v) { return __builtin_amdgcn_rcpf(1.0f + __builtin_amdgcn_exp2f(-1.4426950408889634f * v)); }
__device__ __forceinline__ float bf_lo(unsigned w) { return __builtin_bit_cast(float, w << 16); }
__device__ __forceinline__ float bf_hi(unsigned w) { return __builtin_bit_cast(float, w & 0xffff0000u); }
struct EpiSwiGLU {
    static constexpr bool PERM = true, AFTER_DRAIN = false, HAS_MID = false; static constexpr int MID_T1 = -1, MID_T2 = -1;
    bf16_t* O; int ldc; const PG8_LAS float* ss;
    __device__ __forceinline__ void operator()(const f32x4 (&acc)[2][2][4][2], const Unit& u, int wr, int wc, int fr, int fq) const {
        const int row0 = u.pm * BM + wr * 64 + fr, col0 = u.pn * HALF + wc * 32 + 8 * fq;
#pragma unroll
        for (int ai = 0; ai < 2; ++ai)
#pragma unroll
            for (int m = 0; m < 4; ++m) { const int row = row0 + ai * HALF + m * 16; const float r = rinv_of(ss, u, wr * 64 + fr + ai * HALF + m * 16);
                float h[8];
#pragma unroll
                for (int n = 0; n < 2; ++n)
#pragma unroll
                    for (int j = 0; j < 4; ++j) { const float a = acc[ai][0][m][n][j] * r, b = acc[ai][1][m][n][j] * r; h[4 * n + j] = a * sigm(a) * b; }
                u32x4 w; w.x = cvt_pk_bf16(h[0], h[1]); w.y = cvt_pk_bf16(h[2], h[3]); w.z = cvt_pk_bf16(h[4], h[5]); w.w = cvt_pk_bf16(h[6], h[7]);
                *(u32x4*)(O + (size_t)row * ldc + col0) = w; }
    }
};
template <int ACT> struct EpiScale {
    static constexpr bool PERM = true, AFTER_DRAIN = false, HAS_MID = false; static constexpr int MID_T1 = -1, MID_T2 = -1;
    bf16_t* O; int ldc; const PG8_LAS float* ss;
    __device__ __forceinline__ void operator()(const f32x4 (&acc)[2][2][4][2], const Unit& u, int wr, int wc, int fr, int fq) const {
        const int row0 = u.pm * BM + wr * 64 + fr, col0 = u.pn * BM + wc * 32 + 8 * fq;
#pragma unroll
        for (int ai = 0; ai < 2; ++ai)
#pragma unroll
            for (int m = 0; m < 4; ++m) { const int row = row0 + ai * HALF + m * 16; const float r = rinv_of(ss, u, wr * 64 + fr + ai * HALF + m * 16);
#pragma unroll
                for (int bj = 0; bj < 2; ++bj) { float h[8];
#pragma unroll
                    for (int n = 0; n < 2; ++n)
#pragma unroll
                        for (int j = 0; j < 4; ++j) { const float v = acc[ai][bj][m][n][j] * r; h[4 * n + j] = ACT ? sigm(v) : v; }
                    u32x4 w; w.x = cvt_pk_bf16(h[0], h[1]); w.y = cvt_pk_bf16(h[2], h[3]); w.z = cvt_pk_bf16(h[4], h[5]); w.w = cvt_pk_bf16(h[6], h[7]);
                    *(u32x4*)(O + (size_t)row * ldc + col0 + bj * HALF) = w; } }
    }
};
struct EpiGate8 {
    static constexpr bool PERM = true, AFTER_DRAIN = false, HAS_MID = false; static constexpr int MID_T1 = -1, MID_T2 = -1;
    unsigned char* Gq; int ldg; const PG8_LAS float* ss;
    __device__ __forceinline__ void operator()(const f32x4 (&acc)[2][2][4][2], const Unit& u, int wr, int wc, int fr, int fq) const {
        const int row0 = u.pm * BM + wr * 64 + fr, col0 = u.pn * BM + wc * 32 + 8 * fq;
#pragma unroll
        for (int ai = 0; ai < 2; ++ai)
#pragma unroll
            for (int m = 0; m < 4; ++m) { const int row = row0 + ai * HALF + m * 16; const float r = rinv_of(ss, u, wr * 64 + fr + ai * HALF + m * 16);
#pragma unroll
                for (int bj = 0; bj < 2; ++bj) { unsigned q[8];
#pragma unroll
                    for (int n = 0; n < 2; ++n)
#pragma unroll
                        for (int j = 0; j < 4; ++j) { const float g = sigm(acc[ai][bj][m][n][j] * r) * 255.0f + 0.5f; unsigned qi = (unsigned)g; qi = qi < 1u ? 1u : (qi > 255u ? 255u : qi); q[4 * n + j] = qi; }
                    u32x2 w; w.x = q[0] | (q[1] << 8) | (q[2] << 16) | (q[3] << 24); w.y = q[4] | (q[5] << 8) | (q[6] << 16) | (q[7] << 24);
                    *(u32x2*)(Gq + (size_t)row * ldg + col0 + bj * HALF) = w; } }
    }
};
struct EpiMergeCat {
    static constexpr bool PERM = true, AFTER_DRAIN = false, HAS_MID = true; static constexpr int MID_T1 = 4, MID_T2 = 16;
    const unsigned char* Gq; bf16_t* Mg; int ldg, ldm;
    __device__ __forceinline__ static void unpack8(const u32x2 w, float (&f)[8]) {
        f[0] = (float)(w.x & 255u); f[1] = (float)((w.x >> 8) & 255u); f[2] = (float)((w.x >> 16) & 255u); f[3] = (float)(w.x >> 24);
        f[4] = (float)(w.y & 255u); f[5] = (float)((w.y >> 8) & 255u); f[6] = (float)((w.y >> 16) & 255u); f[7] = (float)(w.y >> 24); }
    __device__ __forceinline__ void mid(f32x4 (&acc)[2][2][4][2], const Unit& u, int t, int wr, int wc, int fr, int fq) const {
        const int row0 = u.pm * BM + wr * 64 + fr, col0 = u.pn * BM + wc * 32 + 8 * fq; const int seg = (t == MID_T1) ? 0 : 2048;
        const unsigned char* gp = Gq + (size_t)row0 * ldg + seg + col0;
#pragma unroll
        for (int ai = 0; ai < 2; ++ai)
#pragma unroll
            for (int mp = 0; mp < 2; ++mp) { u32x2 wn[2][2], wd[2][2];
#pragma unroll
                for (int mi = 0; mi < 2; ++mi)
#pragma unroll
                    for (int bj = 0; bj < 2; ++bj) { const unsigned char* p = gp + (size_t)(ai * HALF + (2 * mp + mi) * 16) * ldg + bj * HALF; wn[mi][bj] = *(const u32x2*)p; wd[mi][bj] = *(const u32x2*)(p + 2048); }
#pragma unroll
                for (int mi = 0; mi < 2; ++mi)
#pragma unroll
                    for (int bj = 0; bj < 2; ++bj)
#pragma unroll
                        for (int n = 0; n < 2; ++n) { const unsigned a_ = n ? wn[mi][bj].y : wn[mi][bj].x, d_ = n ? wd[mi][bj].y : wd[mi][bj].x; f32x4& c = acc[ai][bj][2 * mp + mi][n];
                            c[0] *= (float)(a_ & 255u) * __builtin_amdgcn_rcpf((float)(d_ & 255u)); c[1] *= (float)((a_ >> 8) & 255u) * __builtin_amdgcn_rcpf((float)((d_ >> 8) & 255u));
                            c[2] *= (float)((a_ >> 16) & 255u) * __builtin_amdgcn_rcpf((float)((d_ >> 16) & 255u)); c[3] *= (float)(a_ >> 24) * __builtin_amdgcn_rcpf((float)(d_ >> 24)); }
                asm volatile("" ::: "memory"); }
    }
    __device__ __forceinline__ void operator()(const f32x4 (&acc)[2][2][4][2], const Unit& u, int wr, int wc, int fr, int fq) const {
        const int row0 = u.pm * BM + wr * 64 + fr, col0 = u.pn * BM + wc * 32 + 8 * fq;
        u32x2 wg[2][4][2];
#pragma unroll
        for (int ai = 0; ai < 2; ++ai)
#pragma unroll
            for (int m = 0; m < 4; ++m)
#pragma unroll
                for (int bj = 0; bj < 2; ++bj) wg[ai][m][bj] = *(const u32x2*)(Gq + (size_t)(row0 + ai * HALF + m * 16) * ldg + 4096 + col0 + bj * HALF);
        asm volatile("" ::: "memory");
#pragma unroll
        for (int ai = 0; ai < 2; ++ai)
#pragma unroll
            for (int m = 0; m < 4; ++m) { const int row = row0 + ai * HALF + m * 16; const size_t ro = (size_t)row * ldm + col0;
#pragma unroll
                for (int bj = 0; bj < 2; ++bj) { float fg[8], h[8]; unpack8(wg[ai][m][bj], fg);
#pragma unroll
                    for (int n = 0; n < 2; ++n)
#pragma unroll
                        for (int j = 0; j < 4; ++j) h[4 * n + j] = acc[ai][bj][m][n][j] * (fg[4 * n + j] * (1.0f / 255.0f));
                    u32x4 w; w.x = cvt_pk_bf16(h[0], h[1]); w.y = cvt_pk_bf16(h[2], h[3]); w.z = cvt_pk_bf16(h[4], h[5]); w.w = cvt_pk_bf16(h[6], h[7]);
                    *(u32x4*)(Mg + ro + bj * HALF) = w; } }
    }
};
struct EpiResid {
    static constexpr bool PERM = true, AFTER_DRAIN = false, HAS_MID = false; static constexpr int MID_T1 = -1, MID_T2 = -1;
    bf16_t* xb; float* ssq; float scale; int ldc;
    __device__ __forceinline__ void operator()(const f32x4 (&acc)[2][2][4][2], const Unit& u, int wr, int wc, int fr, int fq) const {
        const int row0 = u.pm * BM + wr * 64 + fr, col0 = u.pn * BM + wc * 32 + 8 * fq;
#pragma unroll
        for (int ai = 0; ai < 2; ++ai) { u32x4 bb[4][2];
#pragma unroll
            for (int m = 0; m < 4; ++m)
#pragma unroll
                for (int bj = 0; bj < 2; ++bj) bb[m][bj] = *(const u32x4*)(xb + (size_t)(row0 + ai * HALF + m * 16) * ldc + col0 + bj * HALF);
            asm volatile("" ::: "memory");
#pragma unroll
            for (int m = 0; m < 4; ++m) { const int row = row0 + ai * HALF + m * 16; const size_t ro = (size_t)row * ldc + col0; float sq = 0.f;
#pragma unroll
                for (int bj = 0; bj < 2; ++bj) { const u32x4 b = bb[m][bj]; float h[8];
                    h[0] = bf_lo(b.x) + scale * acc[ai][bj][m][0][0]; h[1] = bf_hi(b.x) + scale * acc[ai][bj][m][0][1]; h[2] = bf_lo(b.y) + scale * acc[ai][bj][m][0][2]; h[3] = bf_hi(b.y) + scale * acc[ai][bj][m][0][3];
                    h[4] = bf_lo(b.z) + scale * acc[ai][bj][m][1][0]; h[5] = bf_hi(b.z) + scale * acc[ai][bj][m][1][1]; h[6] = bf_lo(b.w) + scale * acc[ai][bj][m][1][2]; h[7] = bf_hi(b.w) + scale * acc[ai][bj][m][1][3];
                    sq += (h[0] * h[0] + h[1] * h[1]) + (h[2] * h[2] + h[3] * h[3]) + (h[4] * h[4] + h[5] * h[5]) + (h[6] * h[6] + h[7] * h[7]);
                    u32x4 w; w.x = cvt_pk_bf16(h[0], h[1]); w.y = cvt_pk_bf16(h[2], h[3]); w.z = cvt_pk_bf16(h[4], h[5]); w.w = cvt_pk_bf16(h[6], h[7]);
                    *(u32x4*)(xb + ro + bj * HALF) = w; }
                sq += __shfl_xor(sq, 16); sq += __shfl_xor(sq, 32);
                if (fq == 0) __hip_atomic_fetch_add(ssq + row, sq, __ATOMIC_RELAXED, __HIP_MEMORY_SCOPE_AGENT); }
            asm volatile("" ::: "memory"); }
    }
};
template <class Epi, class Sched, bool ALIGN_EPI = false, bool SP2 = false>
__device__ __forceinline__ void gemm_phase(PG8_LAS unsigned char* lds, const Gemm g, const Sched& S, const Epi& E) {
    int tid_l = threadIdx.x; asm volatile("" : "+v"(tid_l));
    const int tid = tid_l, wid = __builtin_amdgcn_readfirstlane(tid >> 6), lane = tid & 63, wr = wid >> 2, wc = wid & 3, fr = lane & 15, fq = lane >> 4;
    const int K = g.K, nt = K / BK;
    unsigned voffA[2], voffB[2];
#pragma unroll
    for (int i = 0; i < 2; ++i) { int R, C; stage_rc(tid * 16 + i * 8192, R, C); const int Rb = Epi::PERM ? ((R & ~31) + perm32(R & 31)) : R;
        voffA[i] = (unsigned)(R * g.lda + C) * 2u; voffB[i] = (unsigned)(Rb * g.ldb + C) * 2u; }
    const size_t kstep = (size_t)(BK * 2);
    const size_t hstepA = (size_t)HALF * g.lda * 2, hstepB = (size_t)HALF * g.ldb * 2;
    const size_t tstepA = 2 * hstepA, tstepB = 2 * hstepB;
    const unsigned ldsw = (unsigned)wid * 1024u;
    const int aoff = lds_byte(wr * 64 + fr, fq * 8), boff = lds_byte(wc * 32 + fr, fq * 8);
#define PG8_SA(b, h) (((b) * 2 + (h)) * HTB)
#define PG8_SB(b, h) ((4 + (b) * 2 + (h)) * HTB)
#define PG8_STAGE(bufoff, gbase, voff) do { _Pragma("unroll") for (int _i = 0; _i < 2; ++_i) \
        __builtin_amdgcn_global_load_lds((const unsigned*)((const char*)(gbase) + (voff)[_i]), (PG8_LAS unsigned*)(lds + (bufoff) + ldsw + _i * 8192), 16, 0, 0); } while (0)
#define PG8_LDA(dst, b, h) do { _Pragma("unroll") for (int m = 0; m < 4; ++m) _Pragma("unroll") for (int k = 0; k < 2; ++k) dst[m][k] = *(const PG8_LAS bf16x8*)(lds + PG8_SA(b, h) + aoff + m * 2048 + k * 1024); } while (0)
#define PG8_LDB(dst, b, h) do { _Pragma("unroll") for (int n = 0; n < 2; ++n) _Pragma("unroll") for (int k = 0; k < 2; ++k) dst[n][k] = *(const PG8_LAS bf16x8*)(lds + PG8_SB(b, h) + boff + n * 2048 + k * 1024); } while (0)
#define PG8_MMA(ai, bj, At, Bt) do { __builtin_amdgcn_s_setprio(1); _Pragma("unroll") for (int m = 0; m < 4; ++m) _Pragma("unroll") for (int n = 0; n < 2; ++n) _Pragma("unroll") for (int k = 0; k < 2; ++k) \
        acc[ai][bj][m][n] = __builtin_amdgcn_mfma_f32_16x16x32_bf16(Bt[n][k], At[m][k], acc[ai][bj][m][n], 0, 0, 0); __builtin_amdgcn_s_setprio(0); } while (0)
#define PG8_WAIT_V(n) asm volatile("s_waitcnt vmcnt(" #n ")" ::: "memory")
#define PG8_WAIT_L(n) asm volatile("s_waitcnt lgkmcnt(" #n ")" ::: "memory")
#define PG8_BAR __builtin_amdgcn_s_barrier()
#define PG8_SCHED __builtin_amdgcn_sched_barrier(0)
    Unit cur, nxt; int ui = 0;
    if (!S.next(0, cur)) return;
    f32x4 acc[2][2][4][2];
#pragma unroll
    for (int a = 0; a < 2; ++a)
#pragma unroll
        for (int b = 0; b < 2; ++b)
#pragma unroll
            for (int m = 0; m < 4; ++m)
#pragma unroll
                for (int n = 0; n < 2; ++n) acc[a][b][m][n] = (f32x4){0.f, 0.f, 0.f, 0.f};
    bf16x8 At[4][2], B0[2][2], B1[2][2];
    const char* cA = (const char*)g.A + (size_t)cur.pm * tstepA; const char* cB = (const char*)g.Bt + (size_t)cur.pn * tstepB;
    S.a_ready(cur);
    if constexpr (SP2) {
        PG8_STAGE(PG8_SB(0, 0), cB, voffB); PG8_STAGE(PG8_SB(0, 1), cB + hstepB, voffB); PG8_STAGE(PG8_SA(0, 0), cA, voffA); PG8_STAGE(PG8_SA(0, 1), cA + hstepA, voffA);
        if (wr == 1) PG8_BAR;
        PG8_WAIT_V(2); PG8_BAR;
        PG8_STAGE(PG8_SB(1, 0), cB + kstep, voffB); PG8_STAGE(PG8_SA(1, 0), cA + kstep, voffA); PG8_STAGE(PG8_SB(1, 1), cB + hstepB + kstep, voffB);
        PG8_WAIT_V(6); PG8_BAR;
    } else {
        PG8_STAGE(PG8_SB(0, 0), cB, voffB); PG8_STAGE(PG8_SA(0, 0), cA, voffA); PG8_STAGE(PG8_SB(0, 1), cB + hstepB, voffB); PG8_STAGE(PG8_SA(0, 1), cA + hstepA, voffA);
        if (wr == 1) PG8_BAR;
        PG8_WAIT_V(4); PG8_BAR;
        PG8_STAGE(PG8_SB(1, 0), cB + kstep, voffB); PG8_STAGE(PG8_SA(1, 0), cA + kstep, voffA); PG8_STAGE(PG8_SB(1, 1), cB + hstepB + kstep, voffB);
        PG8_WAIT_V(6); PG8_BAR;
    }
    for (;;) {
        const bool has_next = S.next(ui + 1, nxt);
        const char* nA = has_next ? (const char*)g.A + (size_t)nxt.pm * tstepA : cA; const char* nB = has_next ? (const char*)g.Bt + (size_t)nxt.pn * tstepB : cB;
        for (int t = 0; t < nt; t += 2) {
            const bool last = (t == nt - 2);
            const char* a1 = cA + (size_t)(t + 1) * kstep;
            const char* a2 = last ? nA : cA + (size_t)(t + 2) * kstep; const char* b2 = last ? nB : cB + (size_t)(t + 2) * kstep;
            const char* a3 = a2 + kstep; const char* b3 = b2 + kstep;
            if (last && has_next) S.a_ready(nxt);
            if constexpr (Epi::HAS_MID) { if (t == Epi::MID_T1 || t == Epi::MID_T2) E.mid(acc, cur, t, wr, wc, fr, fq); }
            if constexpr (SP2) {
            PG8_LDB(B0, 0, 0); PG8_LDB(B1, 0, 1); PG8_SCHED; PG8_LDA(At, 0, 0); PG8_STAGE(PG8_SA(1, 1), a1 + hstepA, voffA);
            PG8_WAIT_V(8); PG8_WAIT_L(0); PG8_BAR; PG8_MMA(0, 0, At, B0); PG8_MMA(0, 1, At, B1); PG8_BAR; PG8_SCHED;
            PG8_LDA(At, 0, 1); PG8_STAGE(PG8_SB(0, 0), b2, voffB); PG8_STAGE(PG8_SB(0, 1), b2 + hstepB, voffB); PG8_STAGE(PG8_SA(0, 0), a2, voffA);
            PG8_WAIT_V(8); PG8_WAIT_L(0); PG8_BAR; PG8_MMA(1, 0, At, B0); PG8_MMA(1, 1, At, B1); PG8_BAR; PG8_SCHED;
            PG8_LDB(B0, 1, 0); PG8_LDB(B1, 1, 1); PG8_SCHED; PG8_LDA(At, 1, 0); PG8_STAGE(PG8_SA(0, 1), a2 + hstepA, voffA);
            PG8_WAIT_V(8); PG8_WAIT_L(0); PG8_BAR; PG8_MMA(0, 0, At, B0); PG8_MMA(0, 1, At, B1); PG8_BAR; PG8_SCHED;
            PG8_LDA(At, 1, 1); PG8_STAGE(PG8_SB(1, 0), b3, voffB); PG8_STAGE(PG8_SB(1, 1), b3 + hstepB, voffB); PG8_STAGE(PG8_SA(1, 0), a3, voffA);
            PG8_WAIT_V(8); PG8_WAIT_L(0); PG8_BAR; PG8_MMA(1, 0, At, B0); PG8_MMA(1, 1, At, B1); PG8_BAR; PG8_SCHED;
            } else {
            PG8_LDB(B0, 0, 0); PG8_SCHED; PG8_LDA(At, 0, 0); PG8_STAGE(PG8_SA(1, 1), a1 + hstepA, voffA);
            PG8_WAIT_L(8); PG8_BAR; PG8_WAIT_L(0); PG8_MMA(0, 0, At, B0); PG8_BAR; PG8_SCHED;
            PG8_LDB(B1, 0, 1); PG8_STAGE(PG8_SB(0, 0), b2, voffB);
            PG8_BAR; PG8_WAIT_L(0); PG8_MMA(0, 1, At, B1); PG8_BAR;
            PG8_LDA(At, 0, 1); PG8_STAGE(PG8_SA(0, 0), a2, voffA);
            PG8_BAR; PG8_WAIT_L(0); PG8_MMA(1, 0, At, B0); PG8_BAR; PG8_SCHED;
            PG8_STAGE(PG8_SB(0, 1), b2 + hstepB, voffB);
            PG8_WAIT_V(6); PG8_BAR; PG8_MMA(1, 1, At, B1); PG8_BAR;
            PG8_LDB(B0, 1, 0); PG8_SCHED; PG8_LDA(At, 1, 0); PG8_STAGE(PG8_SA(0, 1), a2 + hstepA, voffA);
            PG8_WAIT_L(8); PG8_BAR; PG8_WAIT_L(0); PG8_MMA(0, 0, At, B0); PG8_BAR; PG8_SCHED;
            PG8_LDB(B1, 1, 1); PG8_STAGE(PG8_SB(1, 0), b3, voffB);
            PG8_BAR; PG8_WAIT_L(0); PG8_MMA(0, 1, At, B1); PG8_BAR;
            PG8_LDA(At, 1, 1); PG8_STAGE(PG8_SA(1, 0), a3, voffA);
            PG8_BAR; PG8_WAIT_L(0); PG8_MMA(1, 0, At, B0); PG8_BAR; PG8_SCHED;
            PG8_STAGE(PG8_SB(1, 1), b3 + hstepB, voffB);
            PG8_WAIT_V(6); PG8_BAR; PG8_MMA(1, 1, At, B1); PG8_BAR;
            }
        }
        if constexpr (ALIGN_EPI) { if (wr == 0) PG8_BAR; }
        if constexpr (!Epi::AFTER_DRAIN) { E(acc, cur, wr, wc, fr, fq); S.done(cur); }
        if (!has_next) break;
#pragma unroll
        for (int a = 0; a < 2; ++a)
#pragma unroll
            for (int b = 0; b < 2; ++b)
#pragma unroll
                for (int m = 0; m < 4; ++m)
#pragma unroll
                    for (int n = 0; n < 2; ++n) acc[a][b][m][n] = (f32x4){0.f, 0.f, 0.f, 0.f};
        cur = nxt; cA = nA; cB = nB; ++ui;
        if constexpr (ALIGN_EPI) { if (wr == 1) PG8_BAR; }
    }
    PG8_WAIT_V(0);
    if constexpr (!ALIGN_EPI) { if (wr == 0) PG8_BAR; }
    PG8_BAR;
    if constexpr (Epi::AFTER_DRAIN) { E.fused(acc, cur, wr, wc, fr, fq, lds, wid, lane); S.done(cur); }
#undef PG8_SA
#undef PG8_SB
#undef PG8_STAGE
#undef PG8_LDA
#undef PG8_LDB
#undef PG8_MMA
#undef PG8_WAIT_V
#undef PG8_WAIT_L
#undef PG8_BAR
#undef PG8_SCHED
}
}

#define LAS __attribute__((address_space(3)))
typedef unsigned short bf16;
typedef unsigned v4u __attribute__((ext_vector_type(4)));
typedef unsigned v2u __attribute__((ext_vector_type(2)));
typedef float f32x4 __attribute__((ext_vector_type(4)));
typedef short bf16x8 __attribute__((ext_vector_type(8)));
constexpr int NWAVES = 8, NTHR = 512;
constexpr int BATCH = 8, SEQ = 2048, DM = 2048, T = BATCH * SEQ, FF = 5632, NMIX = 5120, NIN = 11264, HYW = 768;
constexpr size_t MiB = 1u << 20;
constexpr size_t WS_SS = 0;
constexpr size_t WS_CEN = 256 * 1024;
constexpr size_t WS_ROPE = 512 * 1024;
constexpr size_t WS_BAR = 320 * 1024;
constexpr size_t WS_HH3 = 1536 * 1024;
constexpr size_t WS_LSE = 1 * MiB;
constexpr int XP = 2112;
constexpr size_t WS_WFFIN = 2 * MiB;
constexpr size_t WS_WFFOUT = 48 * MiB;
constexpr size_t WS_WIN = 70 * MiB;
constexpr size_t WS_WBR = 116 * MiB;
constexpr size_t WS_WOUT = 122 * MiB;
constexpr size_t WS_WMKV = 131 * MiB;
constexpr size_t WS_XB = 136 * MiB;
constexpr size_t WS_MEMNB = 202 * MiB;
constexpr size_t WS_MK = 210 * MiB, WS_MV = 212 * MiB;
constexpr size_t WS_KC = 214 * MiB;
constexpr size_t WS_HV = 226 * MiB;
constexpr size_t WS_BIG = 274 * MiB;
constexpr size_t WS_ACT = WS_BIG;
constexpr size_t WS_PROJ = WS_BIG;
constexpr size_t WS_G = WS_BIG, WS_MG = WS_BIG + 96 * MiB;
constexpr size_t WS_YCAT = WS_BIG + 176 * MiB;
constexpr int YCP = 1536;
constexpr size_t WS_END = WS_BIG + 224 * MiB;
constexpr size_t OUT_OG = 0;
constexpr size_t OUT_HZ = 24 * MiB;
constexpr int LDS_BYTES = 147456;
constexpr int LDS_MISC = 147200;
constexpr int NPHASE = 12;

struct Args { const float* in[32]; float* out; unsigned char* ws; int ph_lo, ph_hi; };

#define LDS_WAIT() asm volatile("s_waitcnt lgkmcnt(0)" ::: "memory")
__device__ __forceinline__ unsigned f2bf(float f) { unsigned u = __builtin_bit_cast(unsigned, f); return (u + 0x7fffu + ((u >> 16) & 1u)) >> 16; }
__device__ __forceinline__ unsigned pk2(float lo, float hi) { return f2bf(lo) | (f2bf(hi) << 16); }
__device__ __forceinline__ float bflo(unsigned w) { return __builtin_bit_cast(float, w << 16); }
__device__ __forceinline__ float bfhi(unsigned w) { return __builtin_bit_cast(float, w & 0xffff0000u); }
__device__ __forceinline__ float bf1(unsigned short h) { return __builtin_bit_cast(float, (unsigned)h << 16); }
__device__ __forceinline__ float wave_sum(float v) {
#pragma unroll
    for (int o = 1; o < 64; o <<= 1) v += __shfl_xor(v, o);
    return v;
}
__device__ __forceinline__ float fsin(float x) { return __builtin_amdgcn_sinf(__builtin_amdgcn_fractf(x * 0.15915494309189535f)); }
__device__ __forceinline__ float fcos(float x) { return __builtin_amdgcn_cosf(__builtin_amdgcn_fractf(x * 0.15915494309189535f)); }
__device__ __forceinline__ float fexp(float x) { return __builtin_amdgcn_exp2f(x * 1.4426950408889634f); }

#define XB_TMO      128
#define XB_XCNT(j)  (256  + 64 * (j))
#define XB_XSUB(j)  (1280 + 64 * (j))
#define XB_XGEN(j)  (2304 + 64 * (j))
#define XB_TOP      3328
#define XB_TOPGEN   3392
#define XCD_BAR_WORDS 3456
#define XB_SPIN_CAP (1u << 18)

__device__ __forceinline__ unsigned xb_ld(unsigned* p)              { return __hip_atomic_load(p, __ATOMIC_RELAXED, __HIP_MEMORY_SCOPE_AGENT); }
__device__ __forceinline__ unsigned xb_add(unsigned* p, unsigned v) { return __hip_atomic_fetch_add(p, v, __ATOMIC_RELAXED, __HIP_MEMORY_SCOPE_AGENT); }
__device__ __forceinline__ unsigned xb_xcc_id() { return (unsigned)__builtin_amdgcn_s_getreg((3 << 11) | 20) & 0xFu; }
#define XB_SPIN(cond, bar) do { unsigned _sp = 0; while (cond) { __builtin_amdgcn_s_sleep(1); \
    if ((++_sp & 255u) == 0u) { if (xb_ld(&(bar)[XB_TMO])) break; if (_sp > XB_SPIN_CAP) { atomicAdd(&(bar)[XB_TMO], 1u); break; } } } } while (0)

struct XcdBarrier {
    unsigned* bar; unsigned x;
    volatile LAS unsigned* st;
};

__device__ __forceinline__ XcdBarrier xcd_barrier_post(unsigned* bar, volatile LAS unsigned* st) {
    XcdBarrier b; b.bar = bar; b.x = xb_xcc_id(); b.st = st;
    if (threadIdx.x == 0) (void)xb_add(&bar[XB_XCNT(b.x)], 1u);
    return b;
}
__device__ __forceinline__ void xcd_barrier_complete(unsigned* bar, unsigned x, unsigned& nloc, unsigned& nx) {
    const unsigned G = gridDim.x * gridDim.y * gridDim.z;
    unsigned sum, cnt, mine, sp = 0u;
    for (;;) {
        sum = 0u; cnt = 0u; mine = 0u;
#pragma unroll
        for (unsigned j = 0; j < 16; ++j) { const unsigned c = xb_ld(&bar[XB_XCNT(j)]); sum += c; cnt += (c > 0u) ? 1u : 0u; mine = (j == x) ? c : mine; }
        if (sum == G) break;
        __builtin_amdgcn_s_sleep(1);
        if ((++sp & 255u) == 0u) { if (xb_ld(&bar[XB_TMO])) break; if (sp > XB_SPIN_CAP) { atomicAdd(&bar[XB_TMO], 1u); break; } }
    }
    nloc = mine > 0u ? mine : 1u; nx = cnt > 0u ? cnt : 1u;
}

__device__ __forceinline__ void xcd_barrier(const XcdBarrier& b) {
    asm volatile("s_waitcnt vmcnt(0)" ::: "memory");
    __syncthreads();
    if (threadIdx.x == 0) {
        unsigned* bar = b.bar;
        __builtin_amdgcn_s_waitcnt(0);
        unsigned nloc = b.st[0], nx = b.st[1];
        if (nloc == 0u) { xcd_barrier_complete(bar, b.x, nloc, nx); b.st[0] = nloc; b.st[1] = nx; }
        const unsigned old = xb_add(&bar[XB_XSUB(b.x)], 1u);
        const unsigned gen = old / nloc;
        if (old + 1u == (gen + 1u) * nloc) {
            __builtin_amdgcn_fence(__ATOMIC_RELEASE, "agent");
            asm volatile("s_waitcnt vmcnt(0)" ::: "memory");
            const unsigned og = xb_add(&bar[XB_TOP], 1u);
            const unsigned tg = og / nx;
            if (og + 1u == (tg + 1u) * nx) xb_add(&bar[XB_TOPGEN], 1u);
            else XB_SPIN(xb_ld(&bar[XB_TOPGEN]) == tg, bar);
            __builtin_amdgcn_fence(__ATOMIC_ACQUIRE, "agent");
            xb_add(&bar[XB_XGEN(b.x)], 1u);
            asm volatile("s_waitcnt vmcnt(0)" ::: "memory");
        } else {
            XB_SPIN(xb_ld(&bar[XB_XGEN(b.x)]) == gen, bar);
            __builtin_amdgcn_fence(__ATOMIC_ACQUIRE, "agent");
            asm volatile("s_waitcnt vmcnt(0)" ::: "memory");
        }
    }
    __syncthreads();
}

__device__ __forceinline__ void cvt_load(const float* __restrict__ W, int N, int nblk, int item, int lane, f32x4 (&v)[8]) {
    const int kb = item / nblk, nb = item % nblk, k0 = 64 * kb, n0 = 32 * nb;
#pragma unroll
    for (int i = 0; i < 8; ++i) v[i] = *(const f32x4*)(W + (size_t)(k0 + 8 * i + (lane >> 3)) * N + n0 + 4 * (lane & 7));
}
__device__ __forceinline__ void cvt_store(const f32x4 (&v)[8], int ldw, int nblk, const float* __restrict__ g, bf16* WT, int perm, LAS float* scr, int item, int lane) {
    const int kb = item / nblk, nb = item % nblk, k0 = 64 * kb, n0 = 32 * nb;
#pragma unroll
    for (int i = 0; i < 8; ++i) { const int kk = 8 * i + (lane >> 3); const float gk = g ? g[k0 + kk] : 1.0f; LAS float* d = scr + kk * 33 + 4 * (lane & 7);
        d[0] = v[i].x * gk; d[1] = v[i].y * gk; d[2] = v[i].z * gk; d[3] = v[i].w * gk; }
    LDS_WAIT(); asm volatile("" ::: "memory");
    int d0 = n0;
    if (perm) { const int isb = n0 >= FF ? 1 : 0, j = n0 - isb * FF; d0 = 256 * (j >> 7) + (j & 127) + 128 * isb; }
    const int c = lane & 7;
#pragma unroll
    for (int j = 0; j < 4; ++j) { const int n = (lane >> 3) + 8 * j; const LAS float* s = scr + (8 * c) * 33 + n;
        v4u o; o.x = pk2(s[0 * 33], s[1 * 33]); o.y = pk2(s[2 * 33], s[3 * 33]); o.z = pk2(s[4 * 33], s[5 * 33]); o.w = pk2(s[6 * 33], s[7 * 33]);
        *(v4u*)(WT + (size_t)(d0 + n) * ldw + k0 + 8 * c) = o; }
    LDS_WAIT(); asm volatile("" ::: "memory");
}
__device__ __forceinline__ void cvt_matrix(const float* W, int K, int N, const float* g, bf16* WT, int ldw, int perm, LAS float* scr, int gw, int NGW, int lane) {
    const int nblk = N / 32, nitems = (K / 64) * nblk;
    int it = gw; f32x4 v[8], vn[8];
    if (it < nitems) cvt_load(W, N, nblk, it, lane, v);
    while (it < nitems) { const int nit = it + NGW;
        if (nit < nitems) cvt_load(W, N, nblk, nit, lane, vn);
        cvt_store(v, ldw, nblk, g, WT, perm, scr, it, lane);
#pragma unroll
        for (int i = 0; i < 8; ++i) v[i] = vn[i];
        it = nit; }
}
struct CvtSel { const float* W; const float* g; bf16* WT; int N, nblk, ldw, perm, local; };
__device__ __forceinline__ CvtSel cvt_select(const Args& a, int gi) {
    unsigned char* ws = a.ws; CvtSel c;
    if (gi < 11264)      { c.W = a.in[3];  c.g = a.in[2];  c.WT = (bf16*)(ws + WS_WFFIN);      c.N = NIN;  c.ldw = XP;  c.perm = 1; c.local = gi; }
    else if (gi < 16896) { c.W = a.in[4];  c.g = nullptr;  c.WT = (bf16*)(ws + WS_WFFOUT);     c.N = DM;   c.ldw = FF;  c.perm = 0; c.local = gi - 11264; }
    else if (gi < 28160) { c.W = a.in[6];  c.g = a.in[5];  c.WT = (bf16*)(ws + WS_WIN);        c.N = NIN;  c.ldw = XP;  c.perm = 0; c.local = gi - 16896; }
    else if (gi < 29184) { c.W = a.in[21]; c.g = nullptr;  c.WT = (bf16*)(ws + WS_WMKV);       c.N = 1024; c.ldw = XP;  c.perm = 0; c.local = gi - 28160; }
    else if (gi < 29440) { c.W = a.in[24]; c.g = nullptr;  c.WT = (bf16*)(ws + WS_WBR);        c.N = DM;   c.ldw = YCP; c.perm = 0; c.local = gi - 29184; }
    else if (gi < 30208) { c.W = a.in[25]; c.g = nullptr;  c.WT = (bf16*)(ws + WS_WBR) + 256;  c.N = DM;   c.ldw = YCP; c.perm = 0; c.local = gi - 29440; }
    else if (gi < 30720) { c.W = a.in[26]; c.g = nullptr;  c.WT = (bf16*)(ws + WS_WBR) + 1024; c.N = DM;   c.ldw = YCP; c.perm = 0; c.local = gi - 30208; }
    else                 { c.W = a.in[27]; c.g = nullptr;  c.WT = (bf16*)(ws + WS_WOUT);       c.N = DM;   c.ldw = XP;  c.perm = 0; c.local = gi - 30720; }
    c.nblk = c.N / 32; return c;
}
__device__ __forceinline__ void cvt_all(const Args& a, LAS float* scr, int gw, int NGW, int lane) {
    constexpr int NITEMS = 32768;
    int gi = gw; f32x4 v[8], vn[8];
    if (gi < NITEMS) { const CvtSel c = cvt_select(a, gi); cvt_load(c.W, c.N, c.nblk, c.local, lane, v); }
    while (gi < NITEMS) { const int ng = gi + NGW;
        if (ng < NITEMS) { const CvtSel cn = cvt_select(a, ng); cvt_load(cn.W, cn.N, cn.nblk, cn.local, lane, vn); }
        const CvtSel c = cvt_select(a, gi); cvt_store(v, c.ldw, c.nblk, c.g, c.WT, c.perm, scr, c.local, lane);
#pragma unroll
        for (int i = 0; i < 8; ++i) v[i] = vn[i];
        gi = ng; }
}
#define FMAC(acc_, a_, b_) asm("v_fmac_f32 %0, %1, %2" : "+v"(acc_) : "v"(a_), "v"(b_))
template <int NIN4, int NIN> __device__ __forceinline__ void hy_dense8(const LAS float* hin, const float* __restrict__ W, int ldw, int col, int row0, float (&acc)[8]) {
    float wr[NIN4 * 4];
    const float* __restrict__ wp = W + col;
#pragma unroll
    for (int i = 0; i < NIN4 * 4; ++i) { wr[i] = i < NIN ? wp[0] : 0.f; wp += ldw; }
#pragma unroll
    for (int t = 0; t < 8; ++t) { float s = 0.f;
#pragma unroll
        for (int i4 = 0; i4 < NIN4; ++i4) { const f32x4 h = *(const LAS f32x4*)(hin + (row0 + t) * 64 + 4 * i4); FMAC(s, h.x, wr[4 * i4]); FMAC(s, h.y, wr[4 * i4 + 1]); FMAC(s, h.z, wr[4 * i4 + 2]); FMAC(s, h.w, wr[4 * i4 + 3]); }
        acc[t] = s; }
}
__device__ __forceinline__ void hy_mlp_item(const Args& a, LAS float* buf, int item, int lane) {
    LAS float* A = buf; LAS float* B = buf + 512; const int t0 = item * 8, tl = lane & 7, t = t0 + tl;
    const float tf = (float)t * (1.0f / 2047.0f), wt = (6.283185307179586f * (float)t) * (1.0f / 2048.0f);
#pragma unroll
    for (int k = 0; k < 5; ++k) { const int f = (lane >> 3) + 8 * k; float v = 0.f;
        if (f == 0) v = tf; else if (f <= 16) v = fcos((1e-4f + (float)(f - 1) * ((15.0f - 1e-4f) / 15.0f)) * wt); else if (f <= 32) v = -fsin((1e-4f + (float)(f - 17) * ((15.0f - 1e-4f) / 15.0f)) * wt);
        A[tl * 64 + f] = v; }
    LDS_WAIT(); asm volatile("" ::: "memory");
    const float fr = a.in[18][lane]; float acc[8];
    const float* w1 = a.in[11]; const float* w2 = a.in[13]; const float* w3 = a.in[15];
    asm volatile("" : "+s"(w1), "+s"(w2), "+s"(w3));
    hy_dense8<9, 33>(A, w1, 64, lane, 0, acc);
    { const float bs = a.in[12][lane];
#pragma unroll
      for (int q = 0; q < 8; ++q) B[q * 64 + lane] = fsin(fr * (acc[q] + bs)); }
    LDS_WAIT(); asm volatile("" ::: "memory");
    hy_dense8<16, 64>(B, w2, 64, lane, 0, acc);
    { const float bs = a.in[14][lane];
#pragma unroll
      for (int q = 0; q < 8; ++q) A[q * 64 + lane] = fsin(fr * (acc[q] + bs)); }
    LDS_WAIT(); asm volatile("" ::: "memory");
    hy_dense8<16, 64>(A, w3, 64, lane, 0, acc);
    { const float bs = a.in[16][lane]; float* hh3 = (float*)(a.ws + WS_HH3);
#pragma unroll
      for (int q = 0; q < 8; ++q) hh3[(size_t)(t0 + q) * 64 + lane] = fsin(fr * (acc[q] + bs)); }
    LDS_WAIT(); asm volatile("" ::: "memory");
}
__device__ __forceinline__ void hy_l4_item(const Args& a, LAS float* hb, int item, int lane) {
    const int cg = item % 48, tb = item / 48, t0 = tb * 64, col = cg * 64 + lane;
    const float* hh3 = (const float*)(a.ws + WS_HH3);
#pragma unroll 4
    for (int it = 0; it < 17; ++it) { const int row = it * 4 + (lane >> 4);
        if (row < 65) { const int tt = t0 + row; f32x4 v = {0.f, 0.f, 0.f, 0.f}; if (tt < SEQ) v = *(const f32x4*)(hh3 + (size_t)tt * 64 + 4 * (lane & 15)); *(LAS f32x4*)(hb + row * 64 + 4 * (lane & 15)) = v; } }
    LDS_WAIT(); asm volatile("" ::: "memory");
    const int o = cg / 24, dir = (cg / 12) & 1, c = col % 768;
    const float ad = __builtin_fabsf(-3.0701134573253946f + (float)c * ((-15.350567286626973f + 3.0701134573253946f) / 767.0f));
    float* cen = (float*)(a.ws + WS_CEN); bf16* kcr = (bf16*)(a.ws + WS_KC) + ((size_t)(o * 768 + c)) * 4096;
    float acc[8];
#pragma unroll 1
    for (int blk = 0; blk < 8; ++blk) {
        hy_dense8<16, 64>(hb, a.in[17], 3072, col, 8 * blk + dir, acc);
        float val[8];
#pragma unroll
        for (int e = 0; e < 8; ++e) { const int tt = t0 + 8 * blk + e + dir; val[e] = acc[e] * fexp(-((float)tt * (1.0f / 2047.0f)) * ad); }
        v4u w;
        if (dir == 0) { w.x = pk2(val[0], val[1]); w.y = pk2(val[2], val[3]); w.z = pk2(val[4], val[5]); w.w = pk2(val[6], val[7]); *(v4u*)(kcr + 2048 + t0 + 8 * blk) = w; if (t0 == 0 && blk == 0) cen[(o * 2) * 768 + c] = val[0]; }
        else { w.x = pk2(val[7], val[6]); w.y = pk2(val[5], val[4]); w.z = pk2(val[3], val[2]); w.w = pk2(val[1], val[0]); *(v4u*)(kcr + 2048 - (t0 + 8 * blk + 8)) = w; }
    }
    if (dir == 1 && t0 == 0) { hy_dense8<16, 64>(hb, a.in[17], 3072, col, 0, acc); cen[(o * 2 + 1) * 768 + c] = acc[0]; }
    LDS_WAIT(); asm volatile("" ::: "memory");
}
__device__ __forceinline__ void phase0(const Args& a, LAS unsigned char* lds, int tid, int lane, int wave, int bid, int G) {
    unsigned char* ws = a.ws;
    LAS float* scr = (LAS float*)(lds + wave * 16384);
    const int gw = bid * NWAVES + wave, NGW = G * NWAVES;
    cvt_all(a, scr, gw, NGW, lane);
    { const float* x = a.in[0]; bf16* xb = (bf16*)(ws + WS_XB); float* ss = (float*)(ws + WS_SS);
      int row = gw; f32x4 v[8], vn[8];
      if (row < T) {
#pragma unroll
          for (int j = 0; j < 8; ++j) v[j] = ((const f32x4*)(x + (size_t)row * DM))[lane + 64 * j]; }
      while (row < T) { const int nrow = row + NGW;
          if (nrow < T) {
#pragma unroll
              for (int j = 0; j < 8; ++j) vn[j] = ((const f32x4*)(x + (size_t)nrow * DM))[lane + 64 * j]; }
          v2u* xo = (v2u*)(xb + (size_t)row * XP) + lane; float s = 0.f;
#pragma unroll
          for (int j = 0; j < 8; ++j) { s += (v[j].x * v[j].x + v[j].y * v[j].y) + (v[j].z * v[j].z + v[j].w * v[j].w); v2u o; o.x = pk2(v[j].x, v[j].y); o.y = pk2(v[j].z, v[j].w); xo[64 * j] = o; }
          s = wave_sum(s); if (lane == 0) ss[row] = s;
#pragma unroll
          for (int j = 0; j < 8; ++j) v[j] = vn[j];
          row = nrow; } }
    { const float* mem = a.in[1]; const float* gm = a.in[20]; bf16* mb = (bf16*)(ws + WS_MEMNB);
      for (int row = gw; row < 2048; row += NGW) { const f32x4* xr = (const f32x4*)(mem + (size_t)row * DM) + lane; v2u* xo = (v2u*)(mb + (size_t)row * DM) + lane; f32x4 v[8]; float s = 0.f;
#pragma unroll
          for (int j = 0; j < 8; ++j) { v[j] = xr[64 * j]; s += (v[j].x * v[j].x + v[j].y * v[j].y) + (v[j].z * v[j].z + v[j].w * v[j].w); }
          const float r = __builtin_amdgcn_rsqf(wave_sum(s) * (1.0f / 2048.0f) + 1e-6f);
#pragma unroll
          for (int j = 0; j < 8; ++j) { const f32x4 gg = ((const f32x4*)gm)[lane + 64 * j]; v2u o; o.x = pk2(v[j].x * r * gg.x, v[j].y * r * gg.y); o.y = pk2(v[j].z * r * gg.z, v[j].w * r * gg.w); xo[64 * j] = o; } } }
    { float* ss = (float*)(ws + WS_SS);
      const int gt = bid * NTHR + tid, NGT = G * NTHR;
      for (int idx = gt; idx < 3 * T; idx += NGT) ss[T + idx] = 0.f; }
    for (int it = NGW - 1 - gw; it < 256; it += NGW) hy_mlp_item(a, scr, it, lane);
}

__device__ __forceinline__ void memkv_tile(const Args& a, LAS unsigned char* lds, int tile, int tid, int lane, int wave) {
    unsigned char* ws = a.ws;
    const int rb = tile >> 3, cb = tile & 7, rg = wave & 3, kh = wave >> 2, l15 = lane & 15, l4 = lane >> 4;
    const bf16* A = (const bf16*)(ws + WS_MEMNB) + (size_t)(rb * 64 + rg * 16 + l15) * DM + kh * 1024 + 8 * l4;
    const bf16* Bw = (const bf16*)(ws + WS_WMKV) + (size_t)(cb * 128 + l15) * XP + kh * 1024 + 8 * l4;
    f32x4 acc[8];
#pragma unroll
    for (int nt = 0; nt < 8; ++nt) acc[nt] = (f32x4){0.f, 0.f, 0.f, 0.f};
    bf16x8 af = *(const bf16x8*)A, bfr[8];
#pragma unroll
    for (int nt = 0; nt < 8; ++nt) bfr[nt] = *(const bf16x8*)(Bw + (size_t)nt * 16 * XP);
#pragma unroll 1
    for (int ks = 0; ks < 32; ++ks) { const int kn = ks < 31 ? ks + 1 : 31; const bf16x8 afn = *(const bf16x8*)(A + 32 * kn); bf16x8 bfn[8];
#pragma unroll
        for (int nt = 0; nt < 8; ++nt) bfn[nt] = *(const bf16x8*)(Bw + (size_t)nt * 16 * XP + 32 * kn);
#pragma unroll
        for (int nt = 0; nt < 8; ++nt) acc[nt] = __builtin_amdgcn_mfma_f32_16x16x32_bf16(bfr[nt], af, acc[nt], 0, 0, 0);
        af = afn;
#pragma unroll
        for (int nt = 0; nt < 8; ++nt) bfr[nt] = bfn[nt]; }
    LAS float* red = (LAS float*)lds;
    if (kh == 1) {
#pragma unroll
        for (int nt = 0; nt < 8; ++nt)
#pragma unroll
            for (int v = 0; v < 4; ++v) red[(rg * 32 + nt * 4 + v) * 64 + lane] = acc[nt][v]; }
    __syncthreads();
    if (kh == 0) {
#pragma unroll
        for (int nt = 0; nt < 8; ++nt)
#pragma unroll
            for (int v = 0; v < 4; ++v) acc[nt][v] += red[(rg * 32 + nt * 4 + v) * 64 + lane];
        const int R = rb * 64 + rg * 16 + l15, b = R >> 8, m = R & 255;
        if (cb < 4) { float s = 0.f;
#pragma unroll
            for (int nt = 0; nt < 8; ++nt) s += (acc[nt][0] * acc[nt][0] + acc[nt][1] * acc[nt][1]) + (acc[nt][2] * acc[nt][2] + acc[nt][3] * acc[nt][3]);
            s += __shfl_xor(s, 16); s += __shfl_xor(s, 32);
            const float r = __builtin_amdgcn_rsqf(s * (1.0f / 128.0f) + 1e-6f); const float* gk = a.in[23];
            bf16* mk = (bf16*)(ws + WS_MK) + ((size_t)((b * 4 + cb) * 256 + m)) * 128;
#pragma unroll
            for (int nt = 0; nt < 8; ++nt) { const int d = 16 * nt + 4 * l4; const f32x4 gg = *(const f32x4*)(gk + d); v2u o; o.x = pk2(acc[nt][0] * r * gg.x, acc[nt][1] * r * gg.y); o.y = pk2(acc[nt][2] * r * gg.z, acc[nt][3] * r * gg.w); *(v2u*)(mk + d) = o; }
        } else {
            bf16* mv = (bf16*)(ws + WS_MV) + ((size_t)((b * 4 + (cb - 4)) * 256 + m)) * 128;
#pragma unroll
            for (int nt = 0; nt < 8; ++nt) { const int d = 16 * nt + 4 * l4; v2u o; o.x = pk2(acc[nt][0], acc[nt][1]); o.y = pk2(acc[nt][2], acc[nt][3]); *(v2u*)(mv + d) = o; }
        }
    }
    __syncthreads();
}

__device__ __forceinline__ constexpr float rope_rf(int i) {
    constexpr float RF[16] = {1.591549367e-01f, 7.008652389e-02f, 3.086376376e-02f, 1.359137055e-02f, 5.985185504e-03f, 2.635675715e-03f, 1.160663669e-03f, 5.111175124e-04f,
                              2.250790858e-04f, 9.911730012e-05f, 4.364795313e-05f, 1.922110096e-05f, 8.464330676e-06f, 3.727408739e-06f, 1.641426365e-06f, 7.228293271e-07f};
    return RF[i];
}
template <bool ROPE> __device__ __forceinline__ void row_norm_store(v4u w0, v4u w1, const float* __restrict__ gain, int pos, float scale, LAS unsigned char* dst, int sub) {
    float f[16];
    f[0] = bflo(w0.x); f[1] = bfhi(w0.x); f[2] = bflo(w0.y); f[3] = bfhi(w0.y); f[4] = bflo(w0.z); f[5] = bfhi(w0.z); f[6] = bflo(w0.w); f[7] = bfhi(w0.w);
    f[8] = bflo(w1.x); f[9] = bfhi(w1.x); f[10] = bflo(w1.y); f[11] = bfhi(w1.y); f[12] = bflo(w1.z); f[13] = bfhi(w1.z); f[14] = bflo(w1.w); f[15] = bfhi(w1.w);
    float ss = 0.f;
#pragma unroll
    for (int e = 0; e < 16; ++e) ss += f[e] * f[e];
    ss += __shfl_xor(ss, 1); ss += __shfl_xor(ss, 2); ss += __shfl_xor(ss, 4);
    const float rn = __builtin_amdgcn_rsqf(ss * (1.0f / 128.0f) + 1e-6f);
    const f32x4 g0 = *(const f32x4*)(gain + sub * 16), g1 = *(const f32x4*)(gain + sub * 16 + 4), g2 = *(const f32x4*)(gain + sub * 16 + 8), g3 = *(const f32x4*)(gain + sub * 16 + 12);
    f[0] *= rn * g0.x; f[1] *= rn * g0.y; f[2] *= rn * g0.z; f[3] *= rn * g0.w; f[4] *= rn * g1.x; f[5] *= rn * g1.y; f[6] *= rn * g1.z; f[7] *= rn * g1.w;
    f[8] *= rn * g2.x; f[9] *= rn * g2.y; f[10] *= rn * g2.z; f[11] *= rn * g2.w; f[12] *= rn * g3.x; f[13] *= rn * g3.y; f[14] *= rn * g3.z; f[15] *= rn * g3.w;
    if (ROPE) {
        const float fp = (float)pos;
#pragma unroll
        for (int e = 0; e < 16; ++e) { const float p = __shfl_xor(f[e], 1);
            if (sub < 2) { const float rv = __builtin_amdgcn_fractf(fp * rope_rf(e)); const float c = __builtin_amdgcn_cosf(rv), s = __builtin_amdgcn_sinf(rv); f[e] = (sub == 0) ? (f[e] * c - p * s) : (f[e] * c + p * s); } }
    }
    v4u o0, o1;
    o0.x = pk2(f[0] * scale, f[1] * scale); o0.y = pk2(f[2] * scale, f[3] * scale); o0.z = pk2(f[4] * scale, f[5] * scale); o0.w = pk2(f[6] * scale, f[7] * scale);
    o1.x = pk2(f[8] * scale, f[9] * scale); o1.y = pk2(f[10] * scale, f[11] * scale); o1.z = pk2(f[12] * scale, f[13] * scale); o1.w = pk2(f[14] * scale, f[15] * scale);
    *(LAS v4u*)(dst + sub * 32) = o0; *(LAS v4u*)(dst + sub * 32 + 16) = o1;
}
template <int OFF> __device__ __forceinline__ void tr_read8(unsigned addr, v2u (&r)[8]) {
    asm volatile("ds_read_b64_tr_b16 %0, %8 offset:%9\n\tds_read_b64_tr_b16 %1, %8 offset:%10\n\tds_read_b64_tr_b16 %2, %8 offset:%11\n\tds_read_b64_tr_b16 %3, %8 offset:%12\n\t"
                 "ds_read_b64_tr_b16 %4, %8 offset:%13\n\tds_read_b64_tr_b16 %5, %8 offset:%14\n\tds_read_b64_tr_b16 %6, %8 offset:%15\n\tds_read_b64_tr_b16 %7, %8 offset:%16\n\ts_waitcnt lgkmcnt(0)"
                 : "=&v"(r[0]), "=&v"(r[1]), "=&v"(r[2]), "=&v"(r[3]), "=&v"(r[4]), "=&v"(r[5]), "=&v"(r[6]), "=&v"(r[7])
                 : "v"(addr), "i"(OFF), "i"(OFF + 4352), "i"(OFF + 32), "i"(OFF + 32 + 4352), "i"(OFF + 64), "i"(OFF + 64 + 4352), "i"(OFF + 96), "i"(OFF + 96 + 4352) : "memory");
}
template <int MODE> __device__ __forceinline__ void attn_super(const Args& a, LAS unsigned char* lds, int sitem, int tid_in, int lane_in, int wave) {
    int tid = tid_in; asm volatile("" : "+v"(tid)); const int lane = tid & 63;
    constexpr int RS = 272, NT = MODE == 0 ? 12 : 16;
    constexpr float SCALE = 0.08838834764831845f;
    LAS unsigned char* Ks = lds; LAS unsigned char* Vs = lds + 256 * RS;
    unsigned char* ws = a.ws;
    const bf16* proj = (const bf16*)(ws + WS_PROJ);
    const int rloc = tid >> 3, sub = tid & 7, l15 = lane & 15, l4 = lane >> 4;
    int b, head, n0 = 0, r = 0, dsh = 0, L = 0, g = 0, slot = 0, qc = 0;
    if (MODE == 0) { b = sitem / 96; const int rem = sitem % 96; head = rem >> 4; const int blk0 = (rem & 15) * 2; g = head >> 1; slot = head & 1; dsh = 2 * g; L = SEQ >> dsh; const int nbsh = 5 - dsh; r = blk0 >> nbsh; n0 = blk0 & ((1 << nbsh) - 1); }
    else { b = sitem >> 6; head = (sitem >> 4) & 3; qc = sitem & 15; }
    const int qloc = 16 * wave + l15; int posq = 0, tokq;
    if (MODE == 0) { posq = ((64 * n0 + qloc) << dsh) + r; tokq = b * SEQ + posq; } else tokq = b * SEQ + 128 * qc + qloc;
    v4u qw[4];
    { const bf16* qrow = proj + (size_t)tokq * NMIX + (MODE == 0 ? head * 128 : 4608 + head * 128);
#pragma unroll
      for (int ks = 0; ks < 4; ++ks) qw[ks] = *(const v4u*)(qrow + 32 * ks + 8 * l4); }
    {
        v4u kw[4][2], vw[4][2]; int spos[4]; const bf16* vsrc[4];
#pragma unroll
        for (int ps = 0; ps < 4; ++ps) { const int kj = ps * 64 + rloc; const v4u z = {0u, 0u, 0u, 0u}; kw[ps][0] = z; kw[ps][1] = z; spos[ps] = 0; vsrc[ps] = nullptr;
            if (MODE == 0) { const int mm = 64 * n0 - 64 + kj; const bool ok = mm >= 0 && mm < L; const int sp = ok ? (mm << dsh) + r : 0; spos[ps] = sp;
                if (ok) { const bf16* rowp = proj + (size_t)(b * SEQ + sp) * NMIX + head * 128 + sub * 16; kw[ps][0] = *(const v4u*)(rowp + 768); kw[ps][1] = *(const v4u*)(rowp + 776); vsrc[ps] = rowp + 1536; } }
            else { const size_t ro = ((size_t)((b * 4 + head) * 256 + kj)) * 128 + sub * 16; const bf16* kp = (const bf16*)(ws + WS_MK) + ro; vsrc[ps] = (const bf16*)(ws + WS_MV) + ro;
                kw[ps][0] = *(const v4u*)kp; kw[ps][1] = *(const v4u*)(kp + 8); } }
#pragma unroll
        for (int ps = 0; ps < 4; ++ps) { const int kj = ps * 64 + rloc;
            if (ps == 2) {
#pragma unroll
                for (int p2 = 0; p2 < 4; ++p2) { const v4u z = {0u, 0u, 0u, 0u}; vw[p2][0] = z; vw[p2][1] = z; if (vsrc[p2]) { vw[p2][0] = *(const v4u*)vsrc[p2]; vw[p2][1] = *(const v4u*)(vsrc[p2] + 8); } } }
            if (MODE == 0) row_norm_store<true>(kw[ps][0], kw[ps][1], a.in[8], spos[ps], 1.0f, Ks + kj * RS, sub);
            else { *(LAS v4u*)(Ks + kj * RS + sub * 32) = kw[ps][0]; *(LAS v4u*)(Ks + kj * RS + sub * 32 + 16) = kw[ps][1]; } }
#pragma unroll
        for (int ps = 0; ps < 4; ++ps) { const int kj = ps * 64 + rloc; *(LAS v4u*)(Vs + kj * RS + sub * 32) = vw[ps][0]; *(LAS v4u*)(Vs + kj * RS + sub * 32 + 16) = vw[ps][1]; }
    }
    bf16x8 qf[4];
    {
        const float* gq = MODE == 0 ? a.in[7] : a.in[22];
        float qv[4][8]; float ss = 0.f;
#pragma unroll
        for (int ks = 0; ks < 4; ++ks) { const v4u w = qw[ks];
            qv[ks][0] = bflo(w.x); qv[ks][1] = bfhi(w.x); qv[ks][2] = bflo(w.y); qv[ks][3] = bfhi(w.y); qv[ks][4] = bflo(w.z); qv[ks][5] = bfhi(w.z); qv[ks][6] = bflo(w.w); qv[ks][7] = bfhi(w.w);
#pragma unroll
            for (int e = 0; e < 8; ++e) ss += qv[ks][e] * qv[ks][e]; }
        ss += __shfl_xor(ss, 16); ss += __shfl_xor(ss, 32);
        const float rn = __builtin_amdgcn_rsqf(ss * (1.0f / 128.0f) + 1e-6f);
#pragma unroll
        for (int ks = 0; ks < 4; ++ks) { const f32x4 g0 = *(const f32x4*)(gq + 32 * ks + 8 * l4), g1 = *(const f32x4*)(gq + 32 * ks + 8 * l4 + 4);
            qv[ks][0] *= rn * g0.x; qv[ks][1] *= rn * g0.y; qv[ks][2] *= rn * g0.z; qv[ks][3] *= rn * g0.w; qv[ks][4] *= rn * g1.x; qv[ks][5] *= rn * g1.y; qv[ks][6] *= rn * g1.z; qv[ks][7] *= rn * g1.w; }
        if (MODE == 0) {
#pragma unroll
            for (int e = 0; e < 8; ++e) { const float p = __shfl_xor(qv[0][e], 32); const float rv = __builtin_amdgcn_fractf((float)posq * ((l4 & 1) ? rope_rf(8 + e) : rope_rf(e))); const float c = __builtin_amdgcn_cosf(rv), sn = __builtin_amdgcn_sinf(rv);
                qv[0][e] = (l4 < 2) ? (qv[0][e] * c - p * sn) : (qv[0][e] * c + p * sn); } }
#pragma unroll
        for (int ks = 0; ks < 4; ++ks) { v4u w; w.x = pk2(qv[ks][0] * SCALE, qv[ks][1] * SCALE); w.y = pk2(qv[ks][2] * SCALE, qv[ks][3] * SCALE); w.z = pk2(qv[ks][4] * SCALE, qv[ks][5] * SCALE); w.w = pk2(qv[ks][6] * SCALE, qv[ks][7] * SCALE);
            qf[ks] = __builtin_bit_cast(bf16x8, w); }
    }
    __syncthreads();
    const int kt0 = MODE == 0 ? 4 * (wave >> 2) : 0;
    f32x4 st[NT]; float mx = -3e38f;
#pragma unroll
    for (int t = 0; t < NT; ++t) { const int kt = kt0 + t; f32x4 acc = {0.f, 0.f, 0.f, 0.f};
#pragma unroll
        for (int ks = 0; ks < 4; ++ks) { const bf16x8 kf = *(const LAS bf16x8*)(Ks + (16 * kt + l15) * RS + (32 * ks + 8 * l4) * 2); acc = __builtin_amdgcn_mfma_f32_16x16x32_bf16(kf, qf[ks], acc, 0, 0, 0); }
        if (MODE == 0) {
#pragma unroll
            for (int v = 0; v < 4; ++v) { const int kj = 16 * kt + 4 * l4 + v, rel = kj - 64 - qloc, mm = 64 * n0 - 64 + kj; const bool ok = rel >= -64 && rel <= 64 && mm >= 0 && mm < L; acc[v] = ok ? acc[v] : -1e30f; } }
        st[t] = acc; mx = fmaxf(fmaxf(mx, fmaxf(acc[0], acc[1])), fmaxf(acc[2], acc[3])); }
    mx = fmaxf(mx, __shfl_xor(mx, 16)); mx = fmaxf(mx, __shfl_xor(mx, 32));
    float sum = 0.f;
#pragma unroll
    for (int t = 0; t < NT; ++t)
#pragma unroll
        for (int v = 0; v < 4; ++v) { st[t][v] = fexp(st[t][v] - mx); sum += st[t][v]; }
    sum += __shfl_xor(sum, 16); sum += __shfl_xor(sum, 32);
    const float inv = 1.0f / sum;
    if (MODE == 0 && l4 == 0) ((float*)(ws + WS_LSE))[((size_t)g * T + tokq) * 2 + slot] = mx + __logf(sum);
    v2u pkp[NT];
#pragma unroll
    for (int t = 0; t < NT; ++t) { pkp[t].x = pk2(st[t][0] * inv, st[t][1] * inv); pkp[t].y = pk2(st[t][2] * inv, st[t][3] * inv); }
    asm volatile("" ::: "memory");
    f32x4 oacc[8];
#pragma unroll
    for (int dt = 0; dt < 8; ++dt) oacc[dt] = (f32x4){0.f, 0.f, 0.f, 0.f};
    const unsigned vbase = (unsigned)(size_t)Vs + (unsigned)((16 * kt0 + 4 * l4 + (l15 >> 2)) * RS + (l15 & 3) * 8);
#pragma unroll
    for (int sl = 0; sl < NT / 2; ++sl) {
        v4u pw; pw.x = pkp[2 * sl].x; pw.y = pkp[2 * sl].y; pw.z = pkp[2 * sl + 1].x; pw.w = pkp[2 * sl + 1].y;
        const bf16x8 pf = __builtin_bit_cast(bf16x8, pw);
        const unsigned va = vbase + (unsigned)(sl * 32 * RS);
        v2u rr[8];
        tr_read8<0>(va, rr);
#pragma unroll
        for (int k = 0; k < 4; ++k) { v4u wv; wv.x = rr[2 * k].x; wv.y = rr[2 * k].y; wv.z = rr[2 * k + 1].x; wv.w = rr[2 * k + 1].y; oacc[k] = __builtin_amdgcn_mfma_f32_16x16x32_bf16(__builtin_bit_cast(bf16x8, wv), pf, oacc[k], 0, 0, 0); }
        tr_read8<128>(va, rr);
#pragma unroll
        for (int k = 0; k < 4; ++k) { v4u wv; wv.x = rr[2 * k].x; wv.y = rr[2 * k].y; wv.z = rr[2 * k + 1].x; wv.w = rr[2 * k + 1].y; oacc[4 + k] = __builtin_amdgcn_mfma_f32_16x16x32_bf16(__builtin_bit_cast(bf16x8, wv), pf, oacc[4 + k], 0, 0, 0); }
    }
    bf16* orow = MODE == 0 ? (bf16*)((unsigned char*)a.out + OUT_OG) + ((size_t)g * T + tokq) * 256 + slot * 128 : (bf16*)(ws + WS_YCAT) + (size_t)tokq * YCP + 1024 + head * 128;
#pragma unroll
    for (int dt = 0; dt < 8; ++dt) { v2u o; o.x = pk2(oacc[dt][0], oacc[dt][1]); o.y = pk2(oacc[dt][2], oacc[dt][3]); *(v2u*)(orow + 16 * dt + 4 * l4) = o; }
    __syncthreads();
}
__device__ __forceinline__ void hy_load_tile(const bf16* proj, int b, int t0, int col0, int lane, v4u (&w)[5]) {
    const int rr = lane >> 2, c4 = lane & 3;
#pragma unroll
    for (int it = 0; it < 5; ++it) { const int row = it * 16 + rr, tt = t0 - 1 + row; const v4u z = {0u, 0u, 0u, 0u}; w[it] = z;
        if (row < 66 && tt >= 0 && tt < SEQ) w[it] = *(const v4u*)(proj + (size_t)(b * SEQ + tt) * NMIX + col0 + 8 * c4); }
}
__device__ __forceinline__ void hy_put_tile(const v4u (&w)[5], LAS float* tl, int lane) {
    const int rr = lane >> 2, c4 = lane & 3;
#pragma unroll
    for (int it = 0; it < 5; ++it) { const int row = it * 16 + rr;
        if (row < 66) { LAS float* d = tl + row * 33 + 8 * c4; d[0] = bflo(w[it].x); d[1] = bfhi(w[it].x); d[2] = bflo(w[it].y); d[3] = bfhi(w[it].y); d[4] = bflo(w[it].z); d[5] = bfhi(w[it].z); d[6] = bflo(w[it].w); d[7] = bfhi(w[it].w); } }
}
__device__ __forceinline__ void hy_stage_tile(const bf16* proj, int b, int t0, int col0, LAS float* tl, int lane) { v4u w[5]; hy_load_tile(proj, b, t0, col0, lane, w); hy_put_tile(w, tl, lane); }
__device__ __forceinline__ void hy_conv8(const LAS float* tl, int j, int q, const float* __restrict__ cw, const float* __restrict__ cbv, int ch, float (&o)[8]) {
    const float w0 = cw[ch], w1 = cw[2304 + ch], w2 = cw[4608 + ch], bs = cbv[ch]; float Lr[10];
#pragma unroll
    for (int k = 0; k < 10; ++k) Lr[k] = tl[(8 * q + k) * 33 + j];
#pragma unroll
    for (int e = 0; e < 8; ++e) o[e] = w0 * Lr[e] + w1 * Lr[e + 1] + w2 * Lr[e + 2] + bs;
}
__device__ __forceinline__ void hyprep_decode(int item, int& p, int& b, int& t0, int& c0) { c0 = (item % 24) * 32; t0 = ((item / 24) & 31) * 64; b = (item / 768) & 7; p = item / 6144; }
__device__ __forceinline__ void hyprep_all(const Args& a, LAS float* tl, int gw, int NGW, int lane) {
    constexpr int NIT = 12288;
    const bf16* proj = (const bf16*)(a.ws + WS_PROJ); bf16* hv = (bf16*)(a.ws + WS_HV);
    int item = gw, p, b, t0, c0; v4u w[5], wn[5];
    if (item < NIT) { hyprep_decode(item, p, b, t0, c0); hy_load_tile(proj, b, t0, 2304 + p * 768 + c0, lane, w); }
    while (item < NIT) { const int nit = item + NGW;
        if (nit < NIT) { int p2, b2, t2, c2; hyprep_decode(nit, p2, b2, t2, c2); hy_load_tile(proj, b2, t2, 2304 + p2 * 768 + c2, lane, wn); }
        hyprep_decode(item, p, b, t0, c0);
        hy_put_tile(w, tl, lane);
        LDS_WAIT(); asm volatile("" ::: "memory");
#pragma unroll
        for (int it = 0; it < 4; ++it) { const int j = it * 8 + (lane >> 3), q = lane & 7; float o[8]; hy_conv8(tl, j, q, a.in[9], a.in[10], p * 768 + c0 + j, o);
            v4u wo; wo.x = pk2(o[0], o[1]); wo.y = pk2(o[2], o[3]); wo.z = pk2(o[4], o[5]); wo.w = pk2(o[6], o[7]);
            *(v4u*)(hv + (((size_t)p * 768 + c0 + j) * 8 + b) * SEQ + t0 + 8 * q) = wo; }
        LDS_WAIT(); asm volatile("" ::: "memory");
#pragma unroll
        for (int i = 0; i < 5; ++i) w[i] = wn[i];
        item = nit; }
}
constexpr int HY_US = 2336, HY_PADL = 256, HY_CL = 4352, HY_CSB = HY_CL * 2 + 32;
constexpr int HY_FCP = 8192, HY_UT = HY_FCP + 8 * HY_CSB, HY_LDS_END = HY_UT + 8 * HY_US * 2;
__device__ __forceinline__ void hyconv_phase(const Args& a, LAS unsigned char* lds, int bid, int G, int tid_in, int wave) {
    int tid = tid_in; asm volatile("" : "+v"(tid)); const int lane = tid & 63;
    unsigned char* ws = a.ws;
    LAS unsigned short* fbase = (LAS unsigned short*)lds;
    LAS unsigned char* fcp = lds + HY_FCP;
    LAS unsigned short* uT = (LAS unsigned short*)(lds + HY_UT);
    const bf16* kc = (const bf16*)(ws + WS_KC); const bf16* hv = (const bf16*)(ws + WS_HV); const float* cen = (const float*)(ws + WS_CEN); const float* hbias = a.in[19];
    const int i15 = lane & 15, kq = lane >> 4, bb = lane & 7, ah = (lane >> 3) & 1;
    const LAS unsigned char* cp = fcp + (i15 & 7) * HY_CSB + (2304 + 8 * kq - 8 * (i15 >> 3)) * 2;
    const LAS unsigned short* ub = uT + bb * HY_US + HY_PADL + 16 * ah + 8 * kq;
    for (int i = tid; i < 8 * HY_US / 2; i += NTHR) ((LAS unsigned*)(lds + HY_UT))[i] = 0u;
    int c = bid; v4u fpre = {0u, 0u, 0u, 0u}, upre[4]; float cpre = 0.f;
#pragma unroll
    for (int i = 0; i < 4; ++i) upre[i] = fpre;
    if (c < HYW) {
        fpre = *(const v4u*)(kc + ((size_t)c) * 4096 + tid * 8); cpre = cen[c] + cen[768 + c] + hbias[c];
#pragma unroll
        for (int i = 0; i < 4; ++i) { const int idx = tid + 512 * i; upre[i] = *(const v4u*)(hv + ((size_t)c * 8 + (idx >> 8)) * SEQ + (idx & 255) * 8); } }
    while (c < HYW) {
        __syncthreads();
#pragma unroll
        for (int i = 0; i < 4; ++i) { const int idx = tid + 512 * i; *(LAS v4u*)(uT + (idx >> 8) * HY_US + HY_PADL + (idx & 255) * 8) = upre[i]; }
#pragma unroll
        for (int o = 0; o < 2; ++o) {
            if (o == 1) __syncthreads();
            *(LAS v4u*)(fbase + tid * 8) = fpre;
            const unsigned cbits = f2bf(cpre);
            __syncthreads();
#pragma unroll
            for (int r = 0; r < 8; ++r)
#pragma unroll
                for (int k = 0; k < 5; ++k) { const int y2 = tid + 512 * k;
                    if (y2 < HY_CL / 2) { const int d0 = r - 2 * y2 + 2304, d1 = d0 - 1;
                        unsigned v0 = (d0 > -2048 && d0 < 2048) ? (unsigned)fbase[d0 + 2048] : 0u, v1 = (d1 > -2048 && d1 < 2048) ? (unsigned)fbase[d1 + 2048] : 0u;
                        v0 = d0 == 0 ? cbits : v0; v1 = d1 == 0 ? cbits : v1;
                        *(LAS unsigned*)(fcp + r * HY_CSB + y2 * 4) = v0 | (v1 << 16); } }
            __syncthreads();
            v2u x1r[8];
            if (o == 0) {
                fpre = *(const v4u*)(kc + ((size_t)(768 + c)) * 4096 + tid * 8); cpre = cen[2 * 768 + c] + cen[3 * 768 + c] + hbias[768 + c];
#pragma unroll
                for (int n = 0; n < 8; ++n) x1r[n] = *(const v2u*)(hv + (((size_t)768 + c) * 8 + bb) * SEQ + 256 * wave + 32 * n + 16 * ah + 4 * kq);
            } else { const int cn = c + G;
                if (cn < HYW) { fpre = *(const v4u*)(kc + ((size_t)cn) * 4096 + tid * 8); cpre = cen[cn] + cen[768 + cn] + hbias[cn];
#pragma unroll
                    for (int i = 0; i < 4; ++i) { const int idx = tid + 512 * i; upre[i] = *(const v4u*)(hv + ((size_t)cn * 8 + (idx >> 8)) * SEQ + (idx & 255) * 8); } } }
            f32x4 acc[8];
#pragma unroll
            for (int n = 0; n < 8; ++n) acc[n] = (f32x4){0.f, 0.f, 0.f, 0.f};
            bf16x8 AF[8];
#pragma unroll
            for (int sl = 2; sl < 8; ++sl) AF[sl] = *(const LAS bf16x8*)(cp - 64 * (8 * wave + sl));
            AF[0] = *(const LAS bf16x8*)(cp - 64 * (8 * wave + 8));
            { AF[1] = *(const LAS bf16x8*)(cp - 64 * (8 * wave + 1));
              const bf16x8 bf = *(const LAS bf16x8*)(ub - 32);
#pragma unroll
              for (int n = 0; n < 8; ++n) acc[n] = __builtin_amdgcn_mfma_f32_16x16x32_bf16(AF[(n + 1) & 7], bf, acc[n], 0, 0, 0); }
#pragma unroll 1
            for (int m = 1; m < 9; ++m) {
#pragma unroll
                for (int u = 0; u < 8; ++u) { const int sig = 8 * m + u - 8;
                    AF[(8 - u) & 7] = *(const LAS bf16x8*)(cp - 64 * (8 * wave - sig));
                    const bf16x8 bf = *(const LAS bf16x8*)(ub + 32 * sig);
#pragma unroll
                    for (int n = 0; n < 8; ++n) acc[n] = __builtin_amdgcn_mfma_f32_16x16x32_bf16(AF[(n - u) & 7], bf, acc[n], 0, 0, 0); }
            }
            if (o == 0) {
                __syncthreads();
#pragma unroll
                for (int n = 0; n < 8; ++n) { const int t = 256 * wave + 32 * n + 16 * ah + 4 * kq; const v2u x1 = x1r[n];
                    v2u y; y.x = pk2(acc[n][0] * bflo(x1.x), acc[n][1] * bfhi(x1.x)); y.y = pk2(acc[n][2] * bflo(x1.y), acc[n][3] * bfhi(x1.y)); *(LAS v2u*)(uT + bb * HY_US + HY_PADL + t) = y; }
            } else {
#pragma unroll
                for (int n = 0; n < 8; ++n) { const int t = 256 * wave + 32 * n + 16 * ah + 4 * kq; v2u y; y.x = pk2(acc[n][0], acc[n][1]); y.y = pk2(acc[n][2], acc[n][3]); *(v2u*)((bf16*)((unsigned char*)a.out + OUT_HZ) + ((size_t)c * 8 + bb) * SEQ + t) = y; }
            }
        }
        c += G;
    }
    __syncthreads();
}
__device__ __forceinline__ void hyout_load(const bf16* proj, const bf16* hz, int item, int lane, v4u (&hw)[4], v4u (&w)[5]) {
    const int c0 = (item % 24) * 32, t0 = ((item / 24) & 31) * 64, b = item / 768;
#pragma unroll
    for (int it = 0; it < 4; ++it) { const int j = it * 8 + (lane >> 3), q = lane & 7; hw[it] = *(const v4u*)(hz + ((size_t)(c0 + j) * 8 + b) * SEQ + t0 + 8 * q); }
    hy_load_tile(proj, b, t0, 2304 + 1536 + c0, lane, w);
}
__device__ __forceinline__ void hyout_all(const Args& a, LAS float* tl, int gw, int NGW, int lane) {
    constexpr int NIT = 6144;
    const bf16* proj = (const bf16*)(a.ws + WS_PROJ); const bf16* hz = (const bf16*)((const unsigned char*)a.out + OUT_HZ); bf16* yb = (bf16*)(a.ws + WS_YCAT) + 256;
    LAS float* tl2 = tl + 66 * 33;
    int item = gw; v4u hw[4], w[5], hwn[4], wn[5];
    if (item < NIT) hyout_load(proj, hz, item, lane, hw, w);
    while (item < NIT) { const int nit = item + NGW;
        if (nit < NIT) hyout_load(proj, hz, nit, lane, hwn, wn);
        const int c0 = (item % 24) * 32, t0 = ((item / 24) & 31) * 64, b = item / 768;
        hy_put_tile(w, tl, lane);
        LDS_WAIT(); asm volatile("" ::: "memory");
#pragma unroll
        for (int it = 0; it < 4; ++it) { const int j = it * 8 + (lane >> 3), q = lane & 7; float o[8]; hy_conv8(tl, j, q, a.in[9], a.in[10], 1536 + c0 + j, o);
            LAS float* d = tl2 + (8 * q) * 33 + j;
            d[0] = o[0] * bflo(hw[it].x); d[33] = o[1] * bfhi(hw[it].x); d[2 * 33] = o[2] * bflo(hw[it].y); d[3 * 33] = o[3] * bfhi(hw[it].y);
            d[4 * 33] = o[4] * bflo(hw[it].z); d[5 * 33] = o[5] * bfhi(hw[it].z); d[6 * 33] = o[6] * bflo(hw[it].w); d[7 * 33] = o[7] * bfhi(hw[it].w); }
        LDS_WAIT(); asm volatile("" ::: "memory");
#pragma unroll 4
        for (int it = 0; it < 16; ++it) { const int t = 4 * it + (lane >> 4), j2 = (lane & 15) * 2; const LAS float* sp = tl2 + t * 33 + j2;
            *(unsigned*)(yb + (size_t)(b * SEQ + t0 + t) * YCP + c0 + j2) = pk2(sp[0], sp[1]); }
        LDS_WAIT(); asm volatile("" ::: "memory");
#pragma unroll
        for (int i = 0; i < 4; ++i) hw[i] = hwn[i];
#pragma unroll
        for (int i = 0; i < 5; ++i) w[i] = wn[i];
        item = nit; }
}

constexpr int LDS_RTAB = 131072;
__device__ __forceinline__ const LAS float* fill_rtab(LAS unsigned char* lds, const float* ssrow, const pg8::StaticOrder& S, int tid) {
    LAS float* rt = (LAS float*)(lds + LDS_RTAB); pg8::Unit u;
    float v[12]; bool okv[12];
#pragma unroll
    for (int i = 0; i < 12; ++i) { pg8::Unit ui_; okv[i] = S.next(i, ui_); v[i] = (okv[i] && tid < 256) ? ssrow[ui_.pm * 256 + tid] : 0.f; }
#pragma unroll
    for (int i = 0; i < 12; ++i) if (okv[i] && tid < 256) rt[i * 256 + tid] = __builtin_amdgcn_rsqf(v[i] * (1.0f / 2048.0f) + 1e-6f);
    for (int i = 12; S.next(i, u); ++i) if (tid < 256) rt[i * 256 + tid] = __builtin_amdgcn_rsqf(ssrow[u.pm * 256 + tid] * (1.0f / 2048.0f) + 1e-6f);
    __syncthreads();
    return rt;
}
__global__ void __launch_bounds__(NTHR, 2) mk_fwd(Args a) {
    extern __shared__ __attribute__((aligned(16))) unsigned char lds_raw[];
    LAS unsigned char* lds = (LAS unsigned char*)lds_raw;
    const int tid = threadIdx.x, lane = tid & 63, wave = __builtin_amdgcn_readfirstlane(tid >> 6), bid = blockIdx.x, G = gridDim.x;
    const int gw = bid * NWAVES + wave, NGW = G * NWAVES;
    unsigned char* ws = a.ws;
    const int lo = a.ph_lo, hi = a.ph_hi;
    float* ss = (float*)(ws + WS_SS);
    bf16* xb = (bf16*)(ws + WS_XB);
#ifndef PH_MASK
#define PH_MASK 0xFFF
#endif
#define IN(k) ((((PH_MASK) >> (k)) & 1) && lo <= (k) && (k) < hi)
#ifndef DUP_MASK
#define DUP_MASK 0
#endif
#define REP(k) _Pragma("unroll") for (int rep_ = 0; rep_ < 1 + (((DUP_MASK) >> (k)) & 1); ++rep_)
    { volatile LAS unsigned* misc0 = (volatile LAS unsigned*)(lds + LDS_MISC); if (tid < 2) misc0[tid] = 0u; }
    __syncthreads();
    (void)xcd_barrier_post((unsigned*)(ws + WS_BAR), (volatile LAS unsigned*)(lds + LDS_MISC));
#define GRID_BAR() do { XcdBarrier b_; b_.bar = (unsigned*)(a.ws + WS_BAR); b_.x = xb_xcc_id(); b_.st = (volatile LAS unsigned*)(lds + LDS_MISC); xcd_barrier(b_); } while (0)
#define SEAM(k) do { if (IN(k) && IN((k) + 1)) { if (a.ph_lo < 0) cg::this_grid().sync();   else { XcdBarrier b_; b_.bar = (unsigned*)(a.ws + WS_BAR); b_.x = xb_xcc_id(); b_.st = (volatile LAS unsigned*)(lds + LDS_MISC); xcd_barrier(b_); } } } while (0)
    if (IN(0)) { phase0(a, lds, tid, lane, wave, bid, G); __syncthreads(); }
    SEAM(0);
    if (IN(1)) REP(1) {
        { LAS float* hb = (LAS float*)(lds + wave * 18432); for (int it = gw; it < 1536; it += NGW) hy_l4_item(a, hb, it, lane); __syncthreads(); }
        for (int tile = bid; tile < 256; tile += G) memkv_tile(a, lds, tile, tid, lane, wave);
        pg8::Gemm g{xb, (const bf16*)(ws + WS_WFFIN), T, NIN, DM, XP, XP}; pg8::StaticOrder S; S.init(T, NIN, G, bid);
        pg8::EpiSwiGLU E{(bf16*)(ws + WS_ACT), FF, fill_rtab(lds, ss, S, tid)};
        pg8::gemm_phase<pg8::EpiSwiGLU, pg8::StaticOrder, GEMM_ALIGN, GEMM_SP2>(lds, g, S, E);
    }
    SEAM(1);
    if (IN(2)) {
        pg8::Gemm g{(const bf16*)(ws + WS_ACT), (const bf16*)(ws + WS_WFFOUT), T, DM, FF, FF, FF}; pg8::StaticOrder S; S.init(T, DM, G, bid);
        pg8::EpiResid E{xb, ss + T, 0.5f, XP};
        pg8::gemm_phase<pg8::EpiResid, pg8::StaticOrder, RESID_ALIGN, GEMM_SP2>(lds, g, S, E);
    }
    SEAM(2);
    if (IN(3)) REP(3) {
        pg8::Gemm g{xb, (const bf16*)(ws + WS_WIN), T, NMIX, DM, XP, XP}; pg8::StaticOrder S; S.init(T, NMIX, G, bid);
        pg8::EpiScale<0> E{(bf16*)(ws + WS_PROJ), NMIX, fill_rtab(lds, ss + T, S, tid)};
        pg8::gemm_phase<pg8::EpiScale<0>, pg8::StaticOrder, GEMM_ALIGN, GEMM_SP2>(lds, g, S, E);
    }
    SEAM(3);
    if (IN(4)) REP(4) {
#ifndef P4_ATTN_REPS
#define P4_ATTN_REPS 1
#endif
#ifndef P4_WAVE_REPS
#define P4_WAVE_REPS 1
#endif
#pragma unroll 1
        for (int rp = 0; rp < P4_ATTN_REPS; ++rp) {
        for (int it = bid; it < 768; it += G) attn_super<0>(a, lds, it, tid, lane, wave);
        for (int it = bid; it < 512; it += G) attn_super<1>(a, lds, it, tid, lane, wave);
        }
        LAS float* scr = (LAS float*)(lds + wave * 16384);
#pragma unroll 1
        for (int rp = 0; rp < P4_WAVE_REPS; ++rp) {
        hyprep_all(a, scr, gw, NGW, lane);
        cvt_matrix(a.in[29], DM, NIN, a.in[28], (bf16*)(ws + WS_WFFIN), XP, 1, scr, gw, NGW, lane);
        cvt_matrix(a.in[30], FF, DM, nullptr, (bf16*)(ws + WS_WFFOUT), FF, 0, scr, gw, NGW, lane);
        }
        __syncthreads();
    }
    SEAM(4);
    if (IN(5)) REP(5) {
        hyconv_phase(a, lds, bid, G, tid, wave);
        const float* lse = (const float*)(ws + WS_LSE); const bf16* og = (const bf16*)((const unsigned char*)a.out + OUT_OG); bf16* ya = (bf16*)(ws + WS_YCAT);
        for (int idx = bid * NTHR + tid; idx < T * 32; idx += G * NTHR) { const int token = idx >> 5, c8 = idx & 31, slot = c8 >> 4;
            const float l0 = lse[(size_t)token * 2 + slot], l1 = lse[((size_t)T + token) * 2 + slot], l2 = lse[((size_t)2 * T + token) * 2 + slot];
            const float mx = fmaxf(l0, fmaxf(l1, l2)); float w0 = fexp(l0 - mx), w1 = fexp(l1 - mx), w2 = fexp(l2 - mx); const float inv = 1.0f / (w0 + w1 + w2); w0 *= inv; w1 *= inv; w2 *= inv;
            const v4u o0 = *(const v4u*)(og + (size_t)token * 256 + c8 * 8), o1 = *(const v4u*)(og + ((size_t)T + token) * 256 + c8 * 8), o2 = *(const v4u*)(og + ((size_t)2 * T + token) * 256 + c8 * 8);
            v4u y;
            y.x = pk2(w0 * bflo(o0.x) + w1 * bflo(o1.x) + w2 * bflo(o2.x), w0 * bfhi(o0.x) + w1 * bfhi(o1.x) + w2 * bfhi(o2.x));
            y.y = pk2(w0 * bflo(o0.y) + w1 * bflo(o1.y) + w2 * bflo(o2.y), w0 * bfhi(o0.y) + w1 * bfhi(o1.y) + w2 * bfhi(o2.y));
            y.z = pk2(w0 * bflo(o0.z) + w1 * bflo(o1.z) + w2 * bflo(o2.z), w0 * bfhi(o0.z) + w1 * bfhi(o1.z) + w2 * bfhi(o2.z));
            y.w = pk2(w0 * bflo(o0.w) + w1 * bflo(o1.w) + w2 * bflo(o2.w), w0 * bfhi(o0.w) + w1 * bfhi(o1.w) + w2 * bfhi(o2.w));
            *(v4u*)(ya + (size_t)token * YCP + c8 * 8) = y; }
    }
    SEAM(5);
    if (IN(6)) REP(6) {
        LAS float* scr = (LAS float*)(lds + wave * 18432);
        hyout_all(a, scr, gw, NGW, lane);
        __syncthreads();
    }
    SEAM(6);
    if (IN(7)) REP(7) {
        { pg8::Gemm g{xb, (const bf16*)(ws + WS_WIN) + (size_t)NMIX * XP, T, 3 * DM, DM, XP, XP}; pg8::StaticOrder S; S.init(T, 3 * DM, G, bid);
          pg8::EpiGate8 E{ws + WS_G, 3 * DM, fill_rtab(lds, ss + T, S, tid)};
          pg8::gemm_phase<pg8::EpiGate8, pg8::StaticOrder, GEMM_ALIGN, GEMM_SP2>(lds, g, S, E); }
        GRID_BAR();
        { pg8::Gemm g{(const bf16*)(ws + WS_YCAT), (const bf16*)(ws + WS_WBR), T, DM, YCP, YCP, YCP}; pg8::StaticOrder S; S.init(T, DM, G, bid);
          pg8::EpiMergeCat E{ws + WS_G, (bf16*)(ws + WS_MG), 3 * DM, XP};
          pg8::gemm_phase<pg8::EpiMergeCat, pg8::StaticOrder, GEMM_ALIGN, GEMM_SP2>(lds, g, S, E); }
    }
    SEAM(7);
    if (IN(8)) {
        pg8::Gemm g{(const bf16*)(ws + WS_MG), (const bf16*)(ws + WS_WOUT), T, DM, DM, XP, XP}; pg8::StaticOrder S; S.init(T, DM, G, bid);
        pg8::EpiResid E{xb, ss + 2 * T, 1.0f, XP};
        pg8::gemm_phase<pg8::EpiResid, pg8::StaticOrder, RESID_ALIGN, GEMM_SP2>(lds, g, S, E);
    }
    SEAM(8);
    if (IN(9)) {
        pg8::Gemm g{xb, (const bf16*)(ws + WS_WFFIN), T, NIN, DM, XP, XP}; pg8::StaticOrder S; S.init(T, NIN, G, bid);
        pg8::EpiSwiGLU E{(bf16*)(ws + WS_ACT), FF, fill_rtab(lds, ss + 2 * T, S, tid)};
        pg8::gemm_phase<pg8::EpiSwiGLU, pg8::StaticOrder, GEMM_ALIGN, GEMM_SP2>(lds, g, S, E);
    }
    SEAM(9);
    if (IN(10)) {
        pg8::Gemm g{(const bf16*)(ws + WS_ACT), (const bf16*)(ws + WS_WFFOUT), T, DM, FF, FF, FF}; pg8::StaticOrder S; S.init(T, DM, G, bid);
        pg8::EpiResid E{xb, ss + 3 * T, 0.5f, XP};
        pg8::gemm_phase<pg8::EpiResid, pg8::StaticOrder, RESID_ALIGN, GEMM_SP2>(lds, g, S, E);
    }
    SEAM(10);
    if (IN(11)) {
        const float* gp = a.in[31];
        f32x4 gg[4][2];
#pragma unroll
        for (int j = 0; j < 4; ++j) { const int c8 = (lane + 64 * j) * 8; gg[j][0] = *(const f32x4*)(gp + c8); gg[j][1] = *(const f32x4*)(gp + c8 + 4); }
        int row = gw; v4u w[4], wn[4]; float ssr = 0.f, ssn = 0.f;
        if (row < T) { ssr = ss[3 * T + row];
#pragma unroll
            for (int j = 0; j < 4; ++j) w[j] = ((const v4u*)(xb + (size_t)row * XP))[lane + 64 * j]; }
        while (row < T) { const int nrow = row + NGW;
            if (nrow < T) { ssn = ss[3 * T + nrow];
#pragma unroll
                for (int j = 0; j < 4; ++j) wn[j] = ((const v4u*)(xb + (size_t)nrow * XP))[lane + 64 * j]; }
            f32x4* orow = (f32x4*)(a.out + (size_t)row * DM); const float r = __builtin_amdgcn_rsqf(ssr * (1.0f / 2048.0f) + 1e-6f);
#pragma unroll
            for (int j = 0; j < 4; ++j) { const f32x4 g0 = gg[j][0], g1 = gg[j][1];
                orow[(lane + 64 * j) * 2] = (f32x4){bflo(w[j].x) * r * g0.x, bfhi(w[j].x) * r * g0.y, bflo(w[j].y) * r * g0.z, bfhi(w[j].y) * r * g0.w};
                orow[(lane + 64 * j) * 2 + 1] = (f32x4){bflo(w[j].z) * r * g1.x, bfhi(w[j].z) * r * g1.y, bflo(w[j].w) * r * g1.z, bfhi(w[j].w) * r * g1.w}; }
#pragma unroll
            for (int j = 0; j < 4; ++j) w[j] = wn[j];
            ssr = ssn; row = nrow; }
    }
#ifdef EXTRA_SYNCS
    for (int i = 0; i < EXTRA_SYNCS; ++i) GRID_BAR();
#endif
#undef IN
#undef SEAM
}

extern "C" void kernel_launch(void* const* d_in, const int* in_sizes, int n_in, void* d_out, int out_size, void* d_ws, size_t ws_size, hipStream_t stream) {
    static int grid = 0;
    if (grid == 0) {
        if (n_in != 32 || in_sizes[0] != T * DM || out_size != T * DM || ws_size < WS_END) { fprintf(stderr, "kernel_launch: unexpected problem (n_in %d, in0 %d, out %d, ws %zu < %zu); nothing launched\n", n_in, n_in > 0 ? in_sizes[0] : -1, out_size, ws_size, (size_t)WS_END); grid = -1; return; }
        int dev = 0, cus = 0, per_cu = 0;
        if (hipGetDevice(&dev) != hipSuccess || hipDeviceGetAttribute(&cus, hipDeviceAttributeMultiprocessorCount, dev) != hipSuccess) { fprintf(stderr, "kernel_launch: device query failed\n"); grid = -1; return; }
        if (hipFuncSetAttribute((const void*)mk_fwd, hipFuncAttributeMaxDynamicSharedMemorySize, LDS_BYTES) != hipSuccess) { fprintf(stderr, "kernel_launch: hipFuncSetAttribute failed\n"); grid = -1; return; }
        if (hipOccupancyMaxActiveBlocksPerMultiprocessor(&per_cu, (const void*)mk_fwd, NTHR, LDS_BYTES) != hipSuccess || per_cu < 1) { fprintf(stderr, "kernel_launch: occupancy query says %d\n", per_cu); per_cu = 1; }
        (void)hipGetLastError();
        grid = cus;
    }
    if (grid < 0) return;
    Args a{};
    for (int i = 0; i < 32; ++i) a.in[i] = (const float*)d_in[i];
    a.out = (float*)d_out; a.ws = (unsigned char*)d_ws;
#if MK_N_LAUNCHES == 1
    if (hipMemsetAsync((unsigned char*)d_ws + WS_BAR, 0, XCD_BAR_WORDS * 4, stream) != hipSuccess) { fprintf(stderr, "kernel_launch: memset of the barrier words failed\n"); return; }
    a.ph_lo = 0; a.ph_hi = NPHASE;
    void* args[] = {&a};
    hipError_t e = hipLaunchCooperativeKernel((const void*)mk_fwd, dim3(grid), dim3(NTHR), args, LDS_BYTES, stream);
    if (e != hipSuccess) fprintf(stderr, "kernel_launch: cooperative launch failed: %s (grid %d)\n", hipGetErrorString(e), grid);
#else
    for (int p = 0; p < NPHASE; ++p) { a.ph_lo = p; a.ph_hi = p + 1; hipLaunchKernelGGL(mk_fwd, dim3(grid), dim3(NTHR), LDS_BYTES, stream, a); }
#endif
}
```
